# Optimizing an MI355X kernel written in HIP

```python
import math
import jax, jax.numpy as jnp
from jax import lax
import numpy as np

D_MODEL = 1024
BATCH = 8
SEQ = 4096
DEPTH = 1

HEAD_DIM = 64
NSA_HEADS = 8
NSA_KV_HEADS = 1
NSA_CMP_LEN = 32
NSA_CMP_STRIDE = 16
NSA_CMP_HIDDEN = 256
NSA_SEL_LEN = 64
NSA_SEL_TOPK = 16
NSA_WINDOW = 512
NSA_Q_CHUNK = 64
MOBA_HEADS = 8
MOBA_BLOCK = 256
MOBA_TOPK = 3
MOBA_Q_CHUNK = 32
MIX_WIDTH = (NSA_HEADS + MOBA_HEADS) * HEAD_DIM
IN_SIZES = (NSA_HEADS * HEAD_DIM,) + (NSA_KV_HEADS * HEAD_DIM,) * 6 + (NSA_HEADS * 3,) + (MOBA_HEADS * HEAD_DIM,) * 3
IN_COLS = sum(IN_SIZES)
N_EXPERTS = 256
TOP_K = 8
N_GROUPS = 8
TOPK_GROUPS = 4
D_EXPERT = 256
D_SHARED = 256
ROUTED_SCALE = 2.5
MOE_BLOCK = 128
ROPE_THETA = 10000.0
EPS = 1e-6
NEG = -1e30

kernel_name = "hybrid_nsa_moba_moe_adaln_block"


def rms_norm(x, g):
    xf = x.astype(jnp.float32)
    y = xf * lax.rsqrt(jnp.mean(xf * xf, axis=-1, keepdims=True) + EPS)
    return y * g.astype(jnp.float32)


def rope(t):
    S, dh = t.shape[-2], t.shape[-1]
    inv = ROPE_THETA ** (-jnp.arange(0, dh, 2, dtype=jnp.float32) / dh)
    ang = jnp.arange(S, dtype=jnp.float32)[:, None] * inv[None, :]
    cos, sin = jnp.cos(ang), jnp.sin(ang)
    t1, t2 = jnp.split(t.astype(jnp.float32), 2, axis=-1)
    return jnp.concatenate([t1 * cos - t2 * sin, t2 * cos + t1 * sin], axis=-1).astype(t.dtype)


def masked_softmax(logits, mask):
    l = jnp.where(mask, logits.astype(jnp.float32), NEG)
    return jax.nn.softmax(l, axis=-1) * mask


def split_heads(t, n):
    B, S = t.shape[:2]
    return t.reshape(B, S, n, HEAD_DIM).transpose(0, 2, 1, 3)


def nsa_mixer(q, k_cmp, v_cmp, k_slc, v_slc, k_win, v_win, gates,
              pos_k, w1_k, w2_k, pos_v, w1_v, w2_v):
    B, H, S, dh = q.shape
    G = NSA_KV_HEADS
    R = H // G
    C = NSA_Q_CHUNK
    W = NSA_WINDOW
    scale = dh ** -0.5
    n_cmp = (S - NSA_CMP_LEN) // NSA_CMP_STRIDE + 1
    n_sel = S // NSA_SEL_LEN
    n_top = min(NSA_SEL_TOPK, n_sel)

    cidx = jnp.arange(n_cmp)[:, None] * NSA_CMP_STRIDE + jnp.arange(NSA_CMP_LEN)[None, :]

    def compress(t, pos, w1, w2):
        blk = t[:, :, cidx] + pos
        flat = blk.reshape(B, G, n_cmp, NSA_CMP_LEN * dh)
        return jnp.dot(jax.nn.silu(jnp.dot(flat, w1)), w2)

    kc = compress(k_cmp, pos_k, w1_k, w2_k)
    vc = compress(v_cmp, pos_v, w1_v, w2_v)
    cmp_end = jnp.arange(n_cmp) * NSA_CMP_STRIDE + NSA_CMP_LEN - 1
    cs = jnp.arange(n_cmp)[:, None] * NSA_CMP_STRIDE
    ss = jnp.arange(n_sel)[None, :] * NSA_SEL_LEN
    overlap = ((cs < ss + NSA_SEL_LEN) & (cs + NSA_CMP_LEN > ss)).astype(jnp.float32)

    k_sb = k_slc.reshape(B, G, n_sel, NSA_SEL_LEN, dh)
    v_sb = v_slc.reshape(B, G, n_sel, NSA_SEL_LEN, dh)
    pad = ((0, 0), (0, 0), (W, 0), (0, 0))
    k_wp = jnp.pad(k_win, pad)
    v_wp = jnp.pad(v_win, pad)
    bi = jnp.arange(B)[:, None, None, None]
    gi = jnp.arange(G)[None, :, None, None]
    jsel = jnp.arange(n_sel)

    def chunk(ci):
        c0 = ci * C
        t = c0 + jnp.arange(C)
        qc = lax.dynamic_slice_in_dim(q, c0, C, axis=2).reshape(B, G, R, C, dh)
        s_c = jnp.einsum('bgrcd,bgnd->bgrcn', qc, kc) * scale
        p_c = masked_softmax(s_c, cmp_end[None, :] <= t[:, None])
        o_cmp = jnp.einsum('bgrcn,bgnd->bgrcd', p_c, vc)
        imp = jnp.einsum('bgrcn,nj->bgcj', p_c, overlap)
        cur = t // NSA_SEL_LEN
        valid = jsel[None, :] <= cur[:, None]
        forced = valid & ((jsel[None, :] == 0) | (jsel[None, :] == cur[:, None]) | (jsel[None, :] == cur[:, None] - 1))
        score = jnp.where(forced, jnp.inf, jnp.where(valid, imp, -jnp.inf))
        _, sel = lax.top_k(score, n_top)
        k_g = k_sb[bi, gi, sel]
        v_g = v_sb[bi, gi, sel]
        kpos = sel[..., None] * NSA_SEL_LEN + jnp.arange(NSA_SEL_LEN)
        smask = (kpos <= t[None, None, :, None, None]).reshape(B, G, 1, C, n_top * NSA_SEL_LEN)
        s_s = jnp.einsum('bgrcd,bgcnkd->bgrcnk', qc, k_g).reshape(B, G, R, C, n_top * NSA_SEL_LEN) * scale
        p_s = masked_softmax(s_s, smask)
        o_slc = jnp.einsum('bgrcm,bgcmd->bgrcd', p_s, v_g.reshape(B, G, C, n_top * NSA_SEL_LEN, dh))
        kw = lax.dynamic_slice_in_dim(k_wp, c0, C + W, axis=2)
        vw = lax.dynamic_slice_in_dim(v_wp, c0, C + W, axis=2)
        kp = c0 - W + jnp.arange(C + W)
        wmask = (kp[None, :] <= t[:, None]) & (kp[None, :] > t[:, None] - W) & (kp[None, :] >= 0)
        s_w = jnp.einsum('bgrcd,bgkd->bgrck', qc, kw) * scale
        o_win = jnp.einsum('bgrck,bgkd->bgrcd', masked_softmax(s_w, wmask), vw)
        gc = lax.dynamic_slice_in_dim(gates, c0, C, axis=2).reshape(B, G, R, C, 3)
        o = gc[..., 0:1] * o_cmp + gc[..., 1:2] * o_slc + gc[..., 2:3] * o_win
        return o.reshape(B, H, C, dh)

    out = lax.map(chunk, jnp.arange(S // C))
    return out.transpose(1, 0, 3, 2, 4).reshape(B, S, H * dh)


def moba_mixer(q, k, v):
    B, H, S, dh = q.shape
    C = MOBA_Q_CHUNK
    scale = dh ** -0.5
    nb = -(-S // MOBA_BLOCK)
    pad = ((0, 0), (0, 0), (0, nb * MOBA_BLOCK - S), (0, 0))
    k_b = jnp.pad(k, pad).reshape(B, H, nb, MOBA_BLOCK, dh)
    v_b = jnp.pad(v, pad).reshape(B, H, nb, MOBA_BLOCK, dh)
    k_mean = jnp.mean(k_b.astype(jnp.float32), axis=3)
    n_top = min(MOBA_TOPK, nb)
    bi = jnp.arange(B)[:, None, None, None]
    hi = jnp.arange(H)[None, :, None, None]
    blk_ids = jnp.arange(nb)

    def chunk(ci):
        c0 = ci * C
        t = c0 + jnp.arange(C)
        own = c0 // MOBA_BLOCK
        qc = lax.dynamic_slice_in_dim(q, c0, C, axis=2)
        k_own = lax.dynamic_index_in_dim(k_b, own, axis=2, keepdims=False)
        v_own = lax.dynamic_index_in_dim(v_b, own, axis=2, keepdims=False)
        own_mask = (own * MOBA_BLOCK + jnp.arange(MOBA_BLOCK))[None, :] <= t[:, None]
        gate = jnp.einsum('bhcd,bhnd->bhcn', qc.astype(jnp.float32), k_mean)
        _, sel = lax.top_k(jnp.where(blk_ids < own, gate, -jnp.inf), n_top)
        sel_ok = sel < own
        k_g = k_b[bi, hi, sel]
        v_g = v_b[bi, hi, sel]
        s_own = jnp.einsum('bhcd,bhkd->bhck', qc, k_own)
        s_past = jnp.einsum('bhcd,bhcnkd->bhcnk', qc, k_g).reshape(B, H, C, n_top * MOBA_BLOCK)
        logits = jnp.concatenate([s_own.astype(jnp.float32), s_past.astype(jnp.float32)], axis=-1) * scale
        mask = jnp.concatenate([jnp.broadcast_to(own_mask, (B, H, C, MOBA_BLOCK)),
                                jnp.repeat(sel_ok, MOBA_BLOCK, axis=-1)], axis=-1)
        p = masked_softmax(logits, mask)
        o = jnp.einsum('bhck,bhkd->bhcd', p[..., :MOBA_BLOCK], v_own) + jnp.einsum(
            'bhcm,bhcmd->bhcd', p[..., MOBA_BLOCK:], v_g.reshape(B, H, C, n_top * MOBA_BLOCK, dh))
        return o

    out = lax.map(chunk, jnp.arange(S // C))
    return out.transpose(1, 0, 3, 2, 4).reshape(B, S, H * dh)


def moe_ffn(h, w_router, router_bias, w_eg, w_eu, w_ed, w_sg, w_su, w_sd):
    T, D = h.shape
    scores = jax.nn.sigmoid(jnp.dot(h, w_router).astype(jnp.float32))
    biased = scores + router_bias.astype(jnp.float32)
    grp = biased.reshape(T, N_GROUPS, N_EXPERTS // N_GROUPS)
    grp_score = jnp.sum(lax.top_k(grp, 2)[0], axis=-1)
    _, gsel = lax.top_k(grp_score, TOPK_GROUPS)
    gmask = jnp.any(gsel[:, :, None] == jnp.arange(N_GROUPS)[None, None, :], axis=1)
    emask = jnp.repeat(gmask, N_EXPERTS // N_GROUPS, axis=1)
    _, eidx = lax.top_k(jnp.where(emask, biased, -jnp.inf), TOP_K)
    wts = jnp.take_along_axis(scores, eidx, axis=1)
    wts = wts / jnp.sum(wts, axis=-1, keepdims=True) * ROUTED_SCALE
    A = T * TOP_K
    e_flat = eidx.reshape(A)
    tok_flat = jnp.repeat(jnp.arange(T, dtype=jnp.int32), TOP_K)
    w_flat = wts.reshape(A)
    order = jnp.argsort(e_flat)
    e_s, tok_s, w_s = e_flat[order], tok_flat[order], w_flat[order]
    counts = jnp.bincount(e_flat, length=N_EXPERTS)
    starts = jnp.cumsum(counts) - counts
    padded = (counts + MOE_BLOCK - 1) // MOE_BLOCK * MOE_BLOCK
    pends = jnp.cumsum(padded)
    pstarts = pends - padded
    dest = pstarts[e_s] + jnp.arange(A) - starts[e_s]
    n_blk = -(-A // MOE_BLOCK) + N_EXPERTS
    buf_tok = jnp.zeros((n_blk * MOE_BLOCK,), jnp.int32).at[dest].set(tok_s)
    buf_w = jnp.zeros((n_blk * MOE_BLOCK,), jnp.float32).at[dest].set(w_s)
    blk_exp = jnp.minimum(jnp.searchsorted(pends, jnp.arange(n_blk) * MOE_BLOCK, side='right'), N_EXPERTS - 1)

    def body(acc, xs):
        tok, wt, e = xs
        xb = h[tok]
        y = jnp.dot(jax.nn.silu(jnp.dot(xb, w_eg[e])) * jnp.dot(xb, w_eu[e]), w_ed[e])
        return acc.at[tok].add(y.astype(jnp.float32) * wt[:, None]), None

    routed, _ = lax.scan(body, jnp.zeros((T, D), jnp.float32),
                         (buf_tok.reshape(n_blk, MOE_BLOCK), buf_w.reshape(n_blk, MOE_BLOCK), blk_exp))
    shared = jnp.dot(jax.nn.silu(jnp.dot(h, w_sg)) * jnp.dot(h, w_su), w_sd)
    return routed + shared


def setup_inputs(seed: int = 0) -> dict:
    key = jax.random.key(seed)
    ks = jax.random.split(key, 24)
    f32 = jnp.float32
    D, L, dh = D_MODEL, DEPTH, HEAD_DIM

    def nrm(k, shape, scale):
        return jax.random.normal(k, shape, f32) * scale

    return {
        "x": nrm(ks[0], (BATCH, SEQ, D), 1.0),
        "c": nrm(ks[1], (BATCH, D), 1.0),
        "w_ada": nrm(ks[2], (L, D, 6 * D), 0.5 * D ** -0.5),
        "b_ada": nrm(ks[3], (L, 6 * D), 0.02),
        "g_attn": 1.0 + nrm(ks[4], (L, D), 0.05),
        "w_in": nrm(ks[5], (L, D, IN_COLS), D ** -0.5),
        "cmp_pos_k": nrm(ks[6], (L, NSA_CMP_LEN, dh), 0.1),
        "cmp_w1_k": nrm(ks[7], (L, NSA_CMP_LEN * dh, NSA_CMP_HIDDEN), (NSA_CMP_LEN * dh) ** -0.5),
        "cmp_w2_k": nrm(ks[8], (L, NSA_CMP_HIDDEN, dh), NSA_CMP_HIDDEN ** -0.5),
        "cmp_pos_v": nrm(ks[9], (L, NSA_CMP_LEN, dh), 0.1),
        "cmp_w1_v": nrm(ks[10], (L, NSA_CMP_LEN * dh, NSA_CMP_HIDDEN), (NSA_CMP_LEN * dh) ** -0.5),
        "cmp_w2_v": nrm(ks[11], (L, NSA_CMP_HIDDEN, dh), NSA_CMP_HIDDEN ** -0.5),
        "w_out": nrm(ks[12], (L, MIX_WIDTH, D), MIX_WIDTH ** -0.5),
        "g_ffn": 1.0 + nrm(ks[13], (L, D), 0.05),
        "w_router": nrm(ks[14], (L, D, N_EXPERTS), D ** -0.5),
        "router_bias": nrm(ks[15], (L, N_EXPERTS), 0.01),
        "w_exp_gate": nrm(ks[16], (L, N_EXPERTS, D, D_EXPERT), D ** -0.5),
        "w_exp_up": nrm(ks[17], (L, N_EXPERTS, D, D_EXPERT), D ** -0.5),
        "w_exp_down": nrm(ks[18], (L, N_EXPERTS, D_EXPERT, D), D_EXPERT ** -0.5),
        "w_sh_gate": nrm(ks[19], (L, D, D_SHARED), D ** -0.5),
        "w_sh_up": nrm(ks[20], (L, D, D_SHARED), D ** -0.5),
        "w_sh_down": nrm(ks[21], (L, D_SHARED, D), D_SHARED ** -0.5),
        "g_final": 1.0 + nrm(ks[22], (D,), 0.05),
    }


def reference(x, c, w_ada, b_ada, g_attn, w_in, cmp_pos_k, cmp_w1_k, cmp_w2_k, cmp_pos_v, cmp_w1_v, cmp_w2_v,
              w_out, g_ffn, w_router, router_bias, w_exp_gate, w_exp_up, w_exp_down,
              w_sh_gate, w_sh_up, w_sh_down, g_final):
    B, S, D = x.shape
    G = NSA_KV_HEADS
    offs = np.cumsum(IN_SIZES)[:-1].tolist()
    cond = jax.nn.silu(c.astype(jnp.float32))
    h_res = x.astype(jnp.float32)
    for l in range(DEPTH):
        mod = jnp.dot(cond, w_ada[l]) + b_ada[l]
        sh1, sc1, gt1, sh2, sc2, gt2 = jnp.split(mod, 6, axis=-1)
        h = rms_norm(h_res, g_attn[l]) * (1.0 + sc1[:, None, :]) + sh1[:, None, :]
        proj = jnp.dot(h, w_in[l])
        qa, kc, vc, ksl, vsl, kw, vw, ga, qb, kb, vb = jnp.split(proj, offs, axis=-1)
        gates = jax.nn.sigmoid(ga.astype(jnp.float32)).reshape(B, S, NSA_HEADS, 3).transpose(0, 2, 1, 3)
        o_a = nsa_mixer(rope(split_heads(qa, NSA_HEADS)),
                        rope(split_heads(kc, G)), split_heads(vc, G),
                        rope(split_heads(ksl, G)), split_heads(vsl, G),
                        rope(split_heads(kw, G)), split_heads(vw, G), gates,
                        cmp_pos_k[l], cmp_w1_k[l], cmp_w2_k[l], cmp_pos_v[l], cmp_w1_v[l], cmp_w2_v[l])
        o_b = moba_mixer(rope(split_heads(qb, MOBA_HEADS)), rope(split_heads(kb, MOBA_HEADS)),
                         split_heads(vb, MOBA_HEADS))
        mix = jnp.concatenate([o_a, o_b], axis=-1)
        h_res = h_res + gt1[:, None, :] * jnp.dot(mix, w_out[l])
        h2 = rms_norm(h_res, g_ffn[l]) * (1.0 + sc2[:, None, :]) + sh2[:, None, :]
        y = moe_ffn(h2.reshape(B * S, D), w_router[l], router_bias[l], w_exp_gate[l], w_exp_up[l],
                    w_exp_down[l], w_sh_gate[l], w_sh_up[l], w_sh_down[l])
        h_res = h_res + gt2[:, None, :] * y.reshape(B, S, D)
    return rms_norm(h_res, g_final).astype(x.dtype)
```

```cpp
#include <hip/hip_runtime.h>
#include <hip/hip_cooperative_groups.h>
#include <cstdio>
#include <cstdint>
namespace cg = cooperative_groups;

#ifndef ORACLE
#define ORACLE 0
#endif
#ifndef DBG
#define DBG 0
#endif
#define DI __device__ __forceinline__

typedef unsigned short bf16_t;
typedef __attribute__((ext_vector_type(8))) short bf16x8;
typedef __attribute__((ext_vector_type(4))) short s16x4;
typedef __attribute__((ext_vector_type(16))) float f32x16;

#if ORACLE
typedef float act_t;
constexpr bool kSplit = true;
#else
typedef bf16_t act_t;
constexpr bool kSplit = false;
#endif

constexpr int DM = 1024, NB = 8, SEQ = 4096, NT = NB * SEQ;
constexpr int INC = 2456;
constexpr int NP = 2496;
constexpr int SLOT_KCMP = 8, SLOT_VCMP = 9, SLOT_KSLC = 10, SLOT_VSLC = 11, SLOT_KWIN = 12, SLOT_VWIN = 13, SLOT_GATE = 14;
constexpr int SLOT_MQ = 15, SLOT_MK = 23, SLOT_MV = 31;
constexpr int NEXP = 256, CAP = 32768, NSLOT = 9;
constexpr int SMEM_BYTES = 60 * 1024;
constexpr int NTHREADS = 256;

struct Params {
  const float *x, *c, *w_ada, *b_ada, *g_attn, *w_in, *pos_k, *w1_k, *w2_k, *pos_v, *w1_v, *w2_v, *w_out, *g_ffn,
      *w_router, *router_bias, *w_eg, *w_eu, *w_ed, *w_sg, *w_su, *w_sd, *g_final;
  float* out;
  float *mod, *ropec, *ropes, *rstd1, *kmean, *mixacc, *hres, *scores, *selw, *yacc;
  act_t *proj, *vT_slc, *vT_win, *vT_moba, *hid, *kc, *vcT, *mix, *h2, *abuf, *yslots;
  int *cnt, *list, *ctr;
};

DI bf16_t f2bf(float x) { __bf16 b = (__bf16)x; return __builtin_bit_cast(bf16_t, b); }
DI float bf2f(bf16_t h) { return __uint_as_float(((unsigned)h) << 16); }
DI float sigmoidf_(float x) { return 1.0f / (1.0f + __expf(-x)); }
DI float siluf_(float x) { return x / (1.0f + __expf(-x)); }
DI int crow(int i, int h) { return (i & 3) + 8 * (i >> 2) + 4 * h; }
#define MFMA(a, b, c) __builtin_amdgcn_mfma_f32_32x32x16_bf16((a), (b), (c), 0, 0, 0)

struct RawF { float4 a, b; };
struct RawH { uint4 u; };
template <class T> struct RawOf;
template <> struct RawOf<float> { typedef RawF type; };
template <> struct RawOf<bf16_t> { typedef RawH type; };

DI void raw_load(const float* p, RawF& r) { r.a = *(const float4*)p; r.b = *(const float4*)(p + 4); }
DI void raw_load(const bf16_t* p, RawH& r) { r.u = *(const uint4*)p; }
DI void raw_zero(RawF& r) { r.a = make_float4(0, 0, 0, 0); r.b = r.a; }
DI void raw_zero(RawH& r) { r.u = make_uint4(0, 0, 0, 0); }
DI void raw_floats(const RawF& r, float (&v)[8]) { v[0] = r.a.x; v[1] = r.a.y; v[2] = r.a.z; v[3] = r.a.w; v[4] = r.b.x; v[5] = r.b.y; v[6] = r.b.z; v[7] = r.b.w; }
DI void raw_floats(const RawH& r, float (&v)[8]) {
  v[0] = __uint_as_float(r.u.x << 16); v[1] = __uint_as_float(r.u.x & 0xffff0000u);
  v[2] = __uint_as_float(r.u.y << 16); v[3] = __uint_as_float(r.u.y & 0xffff0000u);
  v[4] = __uint_as_float(r.u.z << 16); v[5] = __uint_as_float(r.u.z & 0xffff0000u);
  v[6] = __uint_as_float(r.u.w << 16); v[7] = __uint_as_float(r.u.w & 0xffff0000u);
}
template <bool SPLIT> DI void cvt8(const float (&v)[8], bf16x8& hi, bf16x8& lo) {
#pragma unroll
  for (int j = 0; j < 8; ++j) {
    bf16_t hh = f2bf(v[j]);
    hi[j] = (short)hh;
    if (SPLIT) lo[j] = (short)f2bf(v[j] - bf2f(hh)); else lo[j] = 0;
  }
}
template <bool SPLIT> DI void raw_frag(const RawF& r, bf16x8& hi, bf16x8& lo) { float v[8]; raw_floats(r, v); cvt8<SPLIT>(v, hi, lo); }
template <bool SPLIT> DI void raw_frag(const RawH& r, bf16x8& hi, bf16x8& lo) { hi = __builtin_bit_cast(bf16x8, r.u); lo = bf16x8{0, 0, 0, 0, 0, 0, 0, 0}; }

DI void st1(float* p, float v) { *p = v; }
DI void st1(bf16_t* p, float v) { *p = f2bf(v); }
DI void st4(float* p, float a, float b, float c, float d) { *(float4*)p = make_float4(a, b, c, d); }
DI void st4(bf16_t* p, float a, float b, float c, float d) {
  uint2 u;
  u.x = (unsigned)f2bf(a) | ((unsigned)f2bf(b) << 16);
  u.y = (unsigned)f2bf(c) | ((unsigned)f2bf(d) << 16);
  *(uint2*)p = u;
}
DI void st8(float* p, const float (&v)[8]) { *(float4*)p = make_float4(v[0], v[1], v[2], v[3]); *(float4*)(p + 4) = make_float4(v[4], v[5], v[6], v[7]); }
DI void st8(bf16_t* p, const float (&v)[8]) {
  uint4 u;
  u.x = (unsigned)f2bf(v[0]) | ((unsigned)f2bf(v[1]) << 16);
  u.y = (unsigned)f2bf(v[2]) | ((unsigned)f2bf(v[3]) << 16);
  u.z = (unsigned)f2bf(v[4]) | ((unsigned)f2bf(v[5]) << 16);
  u.w = (unsigned)f2bf(v[6]) | ((unsigned)f2bf(v[7]) << 16);
  *(uint4*)p = u;
}
DI float ldf(const float* p) { return *p; }
DI float ldf(const bf16_t* p) { return bf2f(*p); }
DI void ld4f(const float* p, float (&v)[4]) { float4 a = *(const float4*)p; v[0] = a.x; v[1] = a.y; v[2] = a.z; v[3] = a.w; }
DI void ld4f(const bf16_t* p, float (&v)[4]) {
  uint2 u = *(const uint2*)p;
  v[0] = __uint_as_float(u.x << 16); v[1] = __uint_as_float(u.x & 0xffff0000u);
  v[2] = __uint_as_float(u.y << 16); v[3] = __uint_as_float(u.y & 0xffff0000u);
}
DI float wave_sum(float v) {
#pragma unroll
  for (int o = 32; o >= 1; o >>= 1) v += __shfl_xor(v, o);
  return v;
}

constexpr int LDA_S = 40;
template <bool SPLIT, int NMAP, class AF, class BF>
DI void gemm_core(unsigned char* smem, int K, const AF& af, const BF& bfn, f32x16 (&acc)[2][2]) {
  bf16_t* As = (bf16_t*)smem;
  bf16_t* Bs = As + 128 * LDA_S;
  bf16_t* Asl = Bs + 128 * LDA_S;
  bf16_t* Bsl = Asl + 128 * LDA_S;
  const int tid = threadIdx.x, lane = tid & 63, wave = __builtin_amdgcn_readfirstlane(tid >> 6), wm = wave >> 1, wn = wave & 1, r32 = lane & 31, h = lane >> 5;
  const int arow0 = tid >> 2, akc = (tid & 3) * 8;
  const int bn = tid & 127, bkc0 = (tid >> 7) * 8;
  typename AF::Raw ra0, ra1;
  float rb0[8], rb1[8];
#pragma unroll
  for (int mi = 0; mi < 2; ++mi)
#pragma unroll
    for (int ni = 0; ni < 2; ++ni)
#pragma unroll
      for (int i = 0; i < 16; ++i) acc[mi][ni][i] = 0.f;

  af.load(arow0, akc, ra0);
  af.load(arow0 + 64, akc, ra1);
#pragma unroll
  for (int j = 0; j < 8; ++j) { rb0[j] = bfn.load(bkc0 + j, bn); rb1[j] = bfn.load(bkc0 + 16 + j, bn); }

  for (int k0 = 0; k0 < K; k0 += 32) {
    __syncthreads();
    {
      bf16x8 hi, lo;
      af.cvt(ra0, arow0, k0 + akc, hi, lo);
      *(bf16x8*)&As[arow0 * LDA_S + akc] = hi;
      if (SPLIT) *(bf16x8*)&Asl[arow0 * LDA_S + akc] = lo;
      af.cvt(ra1, arow0 + 64, k0 + akc, hi, lo);
      *(bf16x8*)&As[(arow0 + 64) * LDA_S + akc] = hi;
      if (SPLIT) *(bf16x8*)&Asl[(arow0 + 64) * LDA_S + akc] = lo;
      cvt8<SPLIT>(rb0, hi, lo);
      *(bf16x8*)&Bs[bn * LDA_S + bkc0] = hi;
      if (SPLIT) *(bf16x8*)&Bsl[bn * LDA_S + bkc0] = lo;
      cvt8<SPLIT>(rb1, hi, lo);
      *(bf16x8*)&Bs[bn * LDA_S + bkc0 + 16] = hi;
      if (SPLIT) *(bf16x8*)&Bsl[bn * LDA_S + bkc0 + 16] = lo;
    }
    __syncthreads();
    if (!SPLIT && k0 + 32 < K) {
      af.load(arow0, k0 + 32 + akc, ra0);
      af.load(arow0 + 64, k0 + 32 + akc, ra1);
#pragma unroll
      for (int j = 0; j < 8; ++j) { rb0[j] = bfn.load(k0 + 32 + bkc0 + j, bn); rb1[j] = bfn.load(k0 + 32 + bkc0 + 16 + j, bn); }
    }
#pragma unroll
    for (int ks = 0; ks < 2; ++ks) {
      bf16x8 a[2], al[2];
#pragma unroll
      for (int mi = 0; mi < 2; ++mi) {
        const int off = (wm * 64 + mi * 32 + r32) * LDA_S + ks * 16 + h * 8;
        a[mi] = *(const bf16x8*)&As[off];
        if (SPLIT) al[mi] = *(const bf16x8*)&Asl[off];
      }
#pragma unroll
      for (int ni = 0; ni < 2; ++ni) {
        const int nrow = (NMAP == 0) ? (wn * 64 + ni * 32) : (ni == 0 ? wn * 32 : 64 + wn * 32);
        const int off = (nrow + r32) * LDA_S + ks * 16 + h * 8;
        const bf16x8 b = *(const bf16x8*)&Bs[off];
        bf16x8 bl;
        if (SPLIT) bl = *(const bf16x8*)&Bsl[off];
#pragma unroll
        for (int mi = 0; mi < 2; ++mi) {
          acc[mi][ni] = MFMA(a[mi], b, acc[mi][ni]);
          if (SPLIT) {
            acc[mi][ni] = MFMA(al[mi], b, acc[mi][ni]);
            acc[mi][ni] = MFMA(a[mi], bl, acc[mi][ni]);
          }
        }
      }
    }
    if (SPLIT && k0 + 32 < K) {
      af.load(arow0, k0 + 32 + akc, ra0);
      af.load(arow0 + 64, k0 + 32 + akc, ra1);
#pragma unroll
      for (int j = 0; j < 8; ++j) { rb0[j] = bfn.load(k0 + 32 + bkc0 + j, bn); rb1[j] = bfn.load(k0 + 32 + bkc0 + 16 + j, bn); }
    }
  }
  __syncthreads();
}
constexpr int GEMM_LDS = 4 * 128 * LDA_S * 2;

DI void phase0(const Params& p, unsigned char* smem) {
  const int tid = threadIdx.x, lane = tid & 63, wave = __builtin_amdgcn_readfirstlane(tid >> 6);
  if (blockIdx.x == 0) {
    for (int i = tid; i < NEXP + 1; i += NTHREADS) p.cnt[i] = 0;
    if (tid < 8) p.ctr[tid] = 0;
  }
  constexpr int T_MOD = 192, T_ROPE = 512, T_RSTD = 2048;
  for (int tile = blockIdx.x; tile < T_MOD + T_ROPE + T_RSTD; tile += gridDim.x) {
    if (tile < T_MOD) {
      float* cond = (float*)smem;
      float* red = cond + 8 * 1024;
      __syncthreads();
      for (int i = tid; i < 8 * 1024; i += NTHREADS) cond[i] = siluf_(p.c[i]);
      __syncthreads();
      const int col = tid & 31, kp = tid >> 5, j0 = tile * 32;
      float a[8];
#pragma unroll
      for (int b = 0; b < 8; ++b) a[b] = 0.f;
      for (int k = kp * 128; k < kp * 128 + 128; ++k) {
        const float w = p.w_ada[(size_t)k * 6144 + j0 + col];
#pragma unroll
        for (int b = 0; b < 8; ++b) a[b] += cond[b * 1024 + k] * w;
      }
#pragma unroll
      for (int b = 0; b < 8; ++b) red[(kp * 8 + b) * 32 + col] = a[b];
      __syncthreads();
      {
        const int b = tid >> 5;
        float s = 0.f;
#pragma unroll
        for (int q = 0; q < 8; ++q) s += red[(q * 8 + b) * 32 + col];
        p.mod[b * 6144 + j0 + col] = s + p.b_ada[j0 + col];
      }
    } else if (tile < T_MOD + T_ROPE) {
      const int idx = (tile - T_MOD) * 256 + tid;
      const int pos = idx >> 5, i = idx & 31;
      const float inv = (float)pow(10000.0, -(double)(2 * i) / 64.0);
      const float ang = (float)pos * inv;
      p.ropec[idx] = (float)cos((double)ang);
      p.ropes[idx] = (float)sin((double)ang);
    } else {
      const int r0 = (tile - T_MOD - T_ROPE) * 16 + wave * 4;
#pragma unroll
      for (int rr = 0; rr < 4; ++rr) {
        const float* xr = p.x + (size_t)(r0 + rr) * DM;
        float ss = 0.f;
#pragma unroll
        for (int j = 0; j < 4; ++j) {
          const float4 v = *(const float4*)(xr + lane * 4 + 256 * j);
          ss += v.x * v.x + v.y * v.y + v.z * v.z + v.w * v.w;
        }
        ss = wave_sum(ss);
        if (lane == 0) p.rstd1[r0 + rr] = 1.0f / sqrtf(ss * (1.0f / DM) + 1e-6f);
      }
    }
  }
}

struct AF_norm {
  typedef RawF Raw;
  const float* src;
  const float* rs;
  const float* gsv;
  const float* shv;
  DI void load(int row, int k, Raw& r) const { raw_load(src + (size_t)row * DM + k, r); }
  template <bool SPLIT> DI void cvt_(const Raw& r, int row, int k, bf16x8& hi, bf16x8& lo) const {
    float v[8];
    raw_floats(r, v);
    const float s = rs[row];
#pragma unroll
    for (int j = 0; j < 8; ++j) v[j] = v[j] * s * gsv[k + j] + shv[k + j];
    cvt8<SPLIT>(v, hi, lo);
  }
};
struct AF_norm_s : AF_norm { DI void cvt(const Raw& r, int row, int k, bf16x8& hi, bf16x8& lo) const { cvt_<true>(r, row, k, hi, lo); } };
struct AF_norm_n : AF_norm { DI void cvt(const Raw& r, int row, int k, bf16x8& hi, bf16x8& lo) const { cvt_<kSplit>(r, row, k, hi, lo); } };

struct BF_win {
  const float* w; int n0;
  DI float load(int k, int n) const {
    const int np = n0 + n;
    if (np >= NP || (np >= 920 && np < 960)) return 0.f;
    const int ns = np < 920 ? np : np - 40;
    return w[(size_t)k * INC + ns];
  }
};

DI void phase1(const Params& p, unsigned char* smem) {
  const int tid = threadIdx.x, lane = tid & 63, wave = __builtin_amdgcn_readfirstlane(tid >> 6), wm = wave >> 1, wn = wave & 1, r32 = lane & 31, h = lane >> 5;
  float* rs = (float*)(smem + GEMM_LDS);
  float* gsv = rs + 128;
  float* shv = gsv + 1024;
  for (int tile = blockIdx.x; tile < 256 * 20; tile += gridDim.x) {
    const int mt = tile / 20, nt = tile % 20;
    const int b = mt >> 5, t0 = mt * 128;
    __syncthreads();
    if (tid < 128) rs[tid] = p.rstd1[t0 + tid];
    for (int i = tid; i < 1024; i += NTHREADS) {
      gsv[i] = p.g_attn[i] * (1.0f + p.mod[b * 6144 + 1024 + i]);
      shv[i] = p.mod[b * 6144 + i];
    }
    __syncthreads();
    AF_norm_n af; af.src = p.x + (size_t)t0 * DM; af.rs = rs; af.gsv = gsv; af.shv = shv;
    BF_win bf; bf.w = p.w_in; bf.n0 = nt * 128;
    f32x16 acc[2][2];
    gemm_core<kSplit, 0>(smem, DM, af, bf, acc);
    const int slot = nt * 2 + wn;
    if (slot >= 39) continue;
    const bool is_q = (slot < 8) || (slot >= SLOT_MQ && slot < SLOT_MQ + 8);
    const bool is_rope = is_q || slot == SLOT_KCMP || slot == SLOT_KSLC || slot == SLOT_KWIN || (slot >= SLOT_MK && slot < SLOT_MK + 8);
    const bool is_vt = slot == SLOT_VSLC || slot == SLOT_VWIN || slot >= SLOT_MV;
    const int posb = (mt & 31) * 128;
    if (is_vt && DBG == 12) {
#pragma unroll
      for (int mi = 0; mi < 2; ++mi)
#pragma unroll
        for (int i = 0; i < 16; ++i) {
          const int tl = wm * 64 + mi * 32 + crow(i, h);
          act_t* dst = p.proj + (size_t)(t0 + tl) * NP + slot * 64 + r32;
          st1(dst, acc[mi][0][i]); st1(dst + 32, acc[mi][1][i]);
        }
    }
    if (is_vt) {
      const int vidx = (slot == SLOT_VSLC) ? b : ((slot == SLOT_VWIN) ? 8 + b : 16 + b * 8 + (slot - SLOT_MV));
      act_t* vb = p.vT_slc + (size_t)vidx * 64 * SEQ;
#pragma unroll
      for (int mi = 0; mi < 2; ++mi)
#pragma unroll
        for (int ni = 0; ni < 2; ++ni)
#pragma unroll
          for (int g = 0; g < 4; ++g) {
            const int pos = posb + wm * 64 + mi * 32 + 8 * g + 4 * h;
            const int d = ni * 32 + r32;
            act_t* q_ = vb + (size_t)d * SEQ + pos;
            st1(q_, acc[mi][ni][4 * g]); st1(q_ + 1, acc[mi][ni][4 * g + 1]); st1(q_ + 2, acc[mi][ni][4 * g + 2]); st1(q_ + 3, acc[mi][ni][4 * g + 3]);
          }
    } else {
#pragma unroll
      for (int mi = 0; mi < 2; ++mi)
#pragma unroll
        for (int i = 0; i < 16; ++i) {
          const int tl = wm * 64 + mi * 32 + crow(i, h);
          const int pos = posb + tl;
          float t1 = acc[mi][0][i], t2 = acc[mi][1][i];
          act_t* dst = p.proj + (size_t)(t0 + tl) * NP + slot * 64 + r32;
          if (is_rope) {
            const float cs = p.ropec[pos * 32 + r32], sn = p.ropes[pos * 32 + r32];
            float o1 = t1 * cs - t2 * sn, o2 = t2 * cs + t1 * sn;
            if (is_q) { o1 *= 0.125f; o2 *= 0.125f; }
            st1(dst, o1); st1(dst + 32, o2);
          } else if (slot == SLOT_GATE) {
            if (r32 < 24) st1(dst, sigmoidf_(t1));
          } else {
            st1(dst, t1); st1(dst + 32, t2);
          }
        }
    }
  }
}

struct AF_cmp {
  typedef typename RawOf<act_t>::type Raw;
  const act_t* proj; const float* pos; int r0; int col;
  DI void load(int row, int k, Raw& r) const {
    const int rr = r0 + row, b = rr >> 8, n = rr & 255, l = k >> 6, d = k & 63;
    raw_load(proj + (size_t)(b * SEQ + 16 * n + l) * NP + col + d, r);
  }
  DI void cvt(const Raw& r, int row, int k, bf16x8& hi, bf16x8& lo) const {
    float v[8];
    raw_floats(r, v);
#pragma unroll
    for (int j = 0; j < 8; ++j) v[j] += pos[k + j];
    cvt8<kSplit>(v, hi, lo);
  }
};
struct BF_plain {
  const float* w; int ldb; int n0; int nmax;
  DI float load(int k, int n) const { return (n0 + n) < nmax ? w[(size_t)k * ldb + n0 + n] : 0.f; }
};
template <class T> struct AF_rows {
  typedef typename RawOf<T>::type Raw;
  const T* src; int ld;
  DI void load(int row, int k, Raw& r) const { raw_load(src + (size_t)row * ld + k, r); }
  DI void cvt(const Raw& r, int row, int k, bf16x8& hi, bf16x8& lo) const { raw_frag<kSplit>(r, hi, lo); }
};

DI void phase2a(const Params& p, unsigned char* smem) {
  const int tid = threadIdx.x, lane = tid & 63, wave = __builtin_amdgcn_readfirstlane(tid >> 6), wm = wave >> 1, wn = wave & 1, r32 = lane & 31, h = lane >> 5;
  for (int tile = blockIdx.x; tile < 64 + 128; tile += gridDim.x) {
    if (tile < 64) {
      const int which = tile >> 5, mt = (tile >> 1) & 15, nt = tile & 1;
      AF_cmp af; af.proj = p.proj; af.pos = which ? p.pos_v : p.pos_k; af.r0 = mt * 128; af.col = (which ? SLOT_VCMP : SLOT_KCMP) * 64;
      BF_plain bf; bf.w = which ? p.w1_v : p.w1_k; bf.ldb = 256; bf.n0 = nt * 128; bf.nmax = 256;
      f32x16 acc[2][2];
      gemm_core<kSplit, 0>(smem, 2048, af, bf, acc);
      act_t* hb = p.hid + (size_t)which * 2048 * 256;
#pragma unroll
      for (int mi = 0; mi < 2; ++mi)
#pragma unroll
        for (int ni = 0; ni < 2; ++ni)
#pragma unroll
          for (int i = 0; i < 16; ++i) {
            const int r = mt * 128 + wm * 64 + mi * 32 + crow(i, h);
            const int cc = nt * 128 + wn * 64 + ni * 32 + r32;
            st1(hb + (size_t)r * 256 + cc, siluf_(acc[mi][ni][i]));
          }
    } else {
      const int it = tile - 64, b = it >> 4, blk = it & 15;
      const act_t* src = p.proj + (size_t)(b * SEQ + blk * 256) * NP + SLOT_MK * 64 + 2 * tid;
      float s0 = 0.f, s1 = 0.f;
      for (int t = 0; t < 256; ++t) { s0 += ldf(src + (size_t)t * NP); s1 += ldf(src + (size_t)t * NP + 1); }
      const int c0 = 2 * tid, hd = c0 >> 6, d = c0 & 63;
      float* dst = p.kmean + (size_t)((b * 8 + hd) * 16 + blk) * 64 + d;
      dst[0] = s0 * (1.0f / 256.0f);
      dst[1] = s1 * (1.0f / 256.0f);
    }
  }
}

DI void phase2b(const Params& p, unsigned char* smem) {
  const int tid = threadIdx.x, lane = tid & 63, wave = __builtin_amdgcn_readfirstlane(tid >> 6), wm = wave >> 1, wn = wave & 1, r32 = lane & 31, h = lane >> 5;
  for (int tile = blockIdx.x; tile < 32; tile += gridDim.x) {
    const int which = tile >> 4, mt = tile & 15;
    AF_rows<act_t> af; af.src = p.hid + (size_t)which * 2048 * 256 + (size_t)mt * 128 * 256; af.ld = 256;
    BF_plain bf; bf.w = which ? p.w2_v : p.w2_k; bf.ldb = 64; bf.n0 = 0; bf.nmax = 64;
    f32x16 acc[2][2];
    gemm_core<kSplit, 0>(smem, 256, af, bf, acc);
    if (wn != 0) continue;
    if (which == 0) {
#pragma unroll
      for (int mi = 0; mi < 2; ++mi)
#pragma unroll
        for (int ni = 0; ni < 2; ++ni)
#pragma unroll
          for (int i = 0; i < 16; ++i) {
            const int r = mt * 128 + wm * 64 + mi * 32 + crow(i, h);
            st1(p.kc + (size_t)r * 64 + ni * 32 + r32, acc[mi][ni][i]);
          }
    } else {
#pragma unroll
      for (int mi = 0; mi < 2; ++mi)
#pragma unroll
        for (int ni = 0; ni < 2; ++ni)
#pragma unroll
          for (int g = 0; g < 4; ++g) {
            const int r = mt * 128 + wm * 64 + mi * 32 + 8 * g + 4 * h;
            const int b = r >> 8, n = r & 255, d = ni * 32 + r32;
            st4(p.vcT + (size_t)(b * 64 + d) * 256 + n, acc[mi][ni][4 * g], acc[mi][ni][4 * g + 1], acc[mi][ni][4 * g + 2], acc[mi][ni][4 * g + 3]);
          }
    }
  }
}

constexpr int KS_LD = 72, VS_LD = 68;
constexpr int KS_BYTES = 64 * KS_LD * 2, VS_BYTES = 64 * VS_LD * 2;
struct FlashSt { f32x16 o[2][2]; float m[2]; float l[2]; };
struct AttnLds { bf16_t *Ks, *Vs, *Qs; };
constexpr int QS_BYTES = 4 * 2 * 4 * 64 * 16;

DI void flash_init(FlashSt& st) {
#pragma unroll
  for (int qi = 0; qi < 2; ++qi) {
    st.m[qi] = -1e30f; st.l[qi] = 0.f;
#pragma unroll
    for (int dt = 0; dt < 2; ++dt)
#pragma unroll
      for (int i = 0; i < 16; ++i) st.o[qi][dt][i] = 0.f;
  }
}

DI void qk_tile(const AttnLds& L, f32x16 (&s)[2][2], int lane) {
  const int r32 = lane & 31, h = lane >> 5;
#pragma unroll
  for (int kt = 0; kt < 2; ++kt)
#pragma unroll
    for (int qi = 0; qi < 2; ++qi)
#pragma unroll
      for (int i = 0; i < 16; ++i) s[kt][qi][i] = 0.f;
#pragma unroll
  for (int kt = 0; kt < 2; ++kt)
#pragma unroll
    for (int ks = 0; ks < 4; ++ks) {
      const int off = (kt * 32 + r32) * KS_LD + ks * 16 + h * 8;
      const bf16x8 a = *(const bf16x8*)&L.Ks[off];
#pragma unroll
      for (int qi = 0; qi < 2; ++qi) {
        const bf16x8 qv = *(const bf16x8*)&L.Qs[((qi * 4 + ks) * 64 + lane) * 8];
        s[kt][qi] = MFMA(a, qv, s[kt][qi]);
      }
    }
}

template <class MaskF>
DI void flash_tile(const AttnLds& L, FlashSt& st, bool use_mask, const MaskF& mf, int lane) {
  const int r32 = lane & 31, h = lane >> 5;
  f32x16 s[2][2];
  qk_tile(L, s, lane);
  if (use_mask) {
#pragma unroll
    for (int kt = 0; kt < 2; ++kt)
#pragma unroll
      for (int qi = 0; qi < 2; ++qi)
#pragma unroll
        for (int i = 0; i < 16; ++i)
          if (!mf.vis(qi, kt * 32 + crow(i, h))) s[kt][qi][i] = -INFINITY;
  }
#pragma unroll
  for (int qi = 0; qi < 2; ++qi) {
    float mx = -INFINITY;
#pragma unroll
    for (int kt = 0; kt < 2; ++kt)
#pragma unroll
      for (int i = 0; i < 16; ++i) mx = fmaxf(mx, s[kt][qi][i]);
    mx = fmaxf(mx, __shfl_xor(mx, 32));
    const float mnew = fmaxf(st.m[qi], mx);
    const float alpha = __expf(st.m[qi] - mnew);
    st.m[qi] = mnew;
    float sum = 0.f;
#pragma unroll
    for (int kt = 0; kt < 2; ++kt)
#pragma unroll
      for (int i = 0; i < 16; ++i) {
        const float pv = __expf(s[kt][qi][i] - mnew);
        s[kt][qi][i] = pv;
        sum += pv;
      }
    st.l[qi] = st.l[qi] * alpha + sum;
#pragma unroll
    for (int dt = 0; dt < 2; ++dt)
#pragma unroll
      for (int i = 0; i < 16; ++i) st.o[qi][dt][i] *= alpha;
  }
#pragma unroll
  for (int kt = 0; kt < 2; ++kt)
#pragma unroll
    for (int s2 = 0; s2 < 2; ++s2) {
      bf16x8 vh[2];
#pragma unroll
      for (int dt = 0; dt < 2; ++dt) {
        const int off = (dt * 32 + r32) * VS_LD + kt * 32 + s2 * 16 + 4 * h;
        const s16x4 a0 = *(const s16x4*)&L.Vs[off];
        const s16x4 a1 = *(const s16x4*)&L.Vs[off + 8];
        vh[dt] = __builtin_shufflevector(a0, a1, 0, 1, 2, 3, 4, 5, 6, 7);
      }
#pragma unroll
      for (int qi = 0; qi < 2; ++qi) {
        bf16x8 ph;
#pragma unroll
        for (int j = 0; j < 8; ++j) ph[j] = (short)f2bf(s[kt][qi][8 * s2 + j]);
#pragma unroll
        for (int dt = 0; dt < 2; ++dt) st.o[qi][dt] = MFMA(vh[dt], ph, st.o[qi][dt]);
      }
    }
}

typedef typename RawOf<act_t>::type RawA;
DI void stage_k_load(const act_t* kb, size_t kstride, int tid, RawA (&rk)[2]) {
  const int row = tid >> 3, dc = (tid & 7) * 8;
  raw_load(kb + (size_t)row * kstride + dc, rk[0]);
  raw_load(kb + (size_t)(row + 32) * kstride + dc, rk[1]);
}
DI void stage_v_load(const act_t* vb, size_t vstride, int tid, RawA (&rv)[2]) {
  const int row = tid >> 3, kc = (tid & 7) * 8;
  raw_load(vb + (size_t)row * vstride + kc, rv[0]);
  raw_load(vb + (size_t)(row + 32) * vstride + kc, rv[1]);
}
DI void stage_k_store(const AttnLds& L, int tid, const RawA (&rk)[2]) {
  const int row = tid >> 3, dc = (tid & 7) * 8;
#pragma unroll
  for (int i = 0; i < 2; ++i) {
    bf16x8 hi, lo;
    raw_frag<false>(rk[i], hi, lo);
    *(bf16x8*)&L.Ks[(row + 32 * i) * KS_LD + dc] = hi;
  }
}
DI void stage_v_store(const AttnLds& L, int tid, const RawA (&rv)[2]) {
  const int row = tid >> 3, kc = (tid & 7) * 8;
#pragma unroll
  for (int i = 0; i < 2; ++i) {
    bf16x8 hi, lo;
    raw_frag<false>(rv[i], hi, lo);
    const int off = (row + 32 * i) * VS_LD + kc;
    *(s16x4*)&L.Vs[off] = __builtin_shufflevector(hi, hi, 0, 1, 2, 3);
    *(s16x4*)&L.Vs[off + 4] = __builtin_shufflevector(hi, hi, 4, 5, 6, 7);
  }
}

template <class MaskGen>
DI void run_branch(const AttnLds& L, const act_t* kbase, size_t kstride, const act_t* vbase, size_t vstride, int j0, int j1,
                   MaskGen& mg, FlashSt& st, int tid) {
  const int lane = tid & 63;
  RawA rk[2], rv[2];
  if (j0 < j1) {
    stage_k_load(kbase + (size_t)j0 * 64 * kstride, kstride, tid, rk);
    stage_v_load(vbase + (size_t)j0 * 64, vstride, tid, rv);
  }
  for (int j = j0; j < j1; ++j) {
    __syncthreads();
    stage_k_store(L, tid, rk);
    stage_v_store(L, tid, rv);
    __syncthreads();
#if !ORACLE
    if (j + 1 < j1) {
      stage_k_load(kbase + (size_t)(j + 1) * 64 * kstride, kstride, tid, rk);
      stage_v_load(vbase + (size_t)(j + 1) * 64, vstride, tid, rv);
    }
#endif
    if (!mg.skip(j)) {
      mg.set(j);
      const bool um = mg.needs(j);
      flash_tile(L, st, um, mg, lane);
    }
#if ORACLE
    if (j + 1 < j1) {
      stage_k_load(kbase + (size_t)(j + 1) * 64 * kstride, kstride, tid, rk);
      stage_v_load(vbase + (size_t)(j + 1) * 64, vstride, tid, rv);
    }
#endif
  }
}

struct CmpMask {
  int t; int t0; int jj;
  DI bool skip(int) const { return false; }
  DI void set(int j) { jj = j; }
  DI bool needs(int j) const { return 16 * (64 * j + 63) + 31 > t0; }
  DI bool vis(int, int key) const { return 16 * (64 * jj + key) + 31 <= t; }
};
struct SlcMask {
  unsigned long long msk; int cur; int t; int jj; bool sel;
  DI bool skip(int) const { return false; }
  DI void set(int j) { jj = j; sel = (msk >> j) & 1ull; }
  DI bool needs(int j) const { return (j == cur) || !__all(sel); }
  DI bool vis(int, int key) const { return sel && (64 * jj + key <= t); }
};
struct WinMask {
  int t; int t0; int jj;
  DI bool skip(int) const { return false; }
  DI void set(int j) { jj = j; }
  DI bool needs(int j) const { return (64 * j + 63 > t0) || (64 * j <= t0 + 31 - 512); }
  DI bool vis(int, int key) const { const int kp = 64 * jj + key; return kp <= t && kp > t - 512; }
};
struct MobaMask {
  unsigned mq[2]; int tpos[2]; int ob; int w; int jj; bool s0, s1;
  DI bool skip(int j) const { return j > 4 * ob + w; }
  DI void set(int j) { jj = j; const int jb = j >> 2; s0 = (mq[0] >> jb) & 1u; s1 = (mq[1] >> jb) & 1u; }
  DI bool needs(int j) const { const int jb = j >> 2; return jb < ob ? !__all(s0 && s1) : (j - 4 * ob == w); }
  DI bool vis(int qi, int key) const {
    const int jb = jj >> 2;
    if (jb < ob) return qi == 0 ? s0 : s1;
    return 64 * jj + key <= tpos[qi];
  }
};

DI void load_q(const AttnLds& L, const act_t* qrow, int qi, int lane) {
  const int h = lane >> 5;
#pragma unroll
  for (int ks = 0; ks < 4; ++ks) {
    RawA r;
    bf16x8 hi, lo;
    raw_load(qrow + ks * 16 + h * 8, r);
    raw_frag<false>(r, hi, lo);
    *(bf16x8*)&L.Qs[((qi * 4 + ks) * 64 + lane) * 8] = hi;
  }
}

DI void nsa_item(const Params& p, unsigned char* smem, int b, int qt) {
  int tid_ = threadIdx.x;
  asm volatile("" : "+v"(tid_));
  const int tid = tid_, lane = tid & 63, wave = __builtin_amdgcn_readfirstlane(tid >> 6), r32 = lane & 31, h = lane >> 5;
  AttnLds L;
  L.Ks = (bf16_t*)smem; L.Vs = (bf16_t*)(smem + KS_BYTES); L.Qs = (bf16_t*)(smem + KS_BYTES + VS_BYTES + wave * (QS_BYTES / 4));
  float* impsum = (float*)(smem + KS_BYTES + VS_BYTES + QS_BYTES);
  unsigned long long* selmask = (unsigned long long*)(impsum + 32 * 64);
  float* scr = (float*)(selmask + 32);
  const int t0 = qt * 32, cur = t0 >> 6, t = t0 + r32;
  const size_t tokrow = (size_t)b * SEQ + t;
#pragma unroll
  for (int qi = 0; qi < 2; ++qi) {
    const int hd = 2 * wave + qi;
    load_q(L, p.proj + tokrow * NP + hd * 64, qi, lane);
  }
  const act_t* gatep = p.proj + tokrow * NP + SLOT_GATE * 64 + 6 * wave;
  FlashSt st;
  flash_init(st);
  const int ncmp = (t0 >> 10) + 1;
  {
    CmpMask mg; mg.t = t; mg.t0 = t0; mg.jj = 0;
    run_branch(L, p.kc + (size_t)b * 256 * 64, 64, p.vcT + (size_t)b * 64 * 256, 256, 0, ncmp, mg, st, tid);
  }
  float mc[2], il[2];
#pragma unroll
  for (int qi = 0; qi < 2; ++qi) {
    const float lt = st.l[qi] + __shfl_xor(st.l[qi], 32);
    const float inv = lt > 0.f ? 1.0f / lt : 0.f;
    mc[qi] = st.m[qi]; il[qi] = inv;
    const float gs = ldf(gatep + 3 * qi) * inv;
    float* dst = p.mixacc + tokrow * 512 + (2 * wave + qi) * 64;
#pragma unroll
    for (int dt = 0; dt < 2; ++dt)
#pragma unroll
      for (int g = 0; g < 4; ++g)
        *(float4*)(dst + dt * 32 + 8 * g + 4 * h) = make_float4(st.o[qi][dt][4 * g] * gs, st.o[qi][dt][4 * g + 1] * gs, st.o[qi][dt][4 * g + 2] * gs, st.o[qi][dt][4 * g + 3] * gs);
  }
  unsigned long long msk;
  if (cur >= 16) {
    __syncthreads();
    for (int i = tid; i < 32 * 64; i += NTHREADS) impsum[i] = 0.f;
    for (int j = 0; j < ncmp; ++j) {
      __syncthreads();
      {
        RawA rk[2];
        stage_k_load(p.kc + (size_t)b * 256 * 64 + (size_t)j * 64 * 64, 64, tid, rk);
        stage_k_store(L, tid, rk);
      }
      __syncthreads();
      f32x16 s[2][2];
      qk_tile(L, s, lane);
#pragma unroll
      for (int kt = 0; kt < 2; ++kt)
#pragma unroll
        for (int g = 0; g < 4; ++g) {
          float v4 = 0.f, v3 = 0.f;
#pragma unroll
          for (int e = 0; e < 4; ++e) {
            const int i = 4 * g + e;
            const int n = 64 * j + kt * 32 + crow(i, h);
            float pv = 0.f;
            if (16 * n + 31 <= t) pv = __expf(s[kt][0][i] - mc[0]) * il[0] + __expf(s[kt][1][i] - mc[1]) * il[1];
            v4 += pv;
            if (e == 3) v3 = pv;
          }
          const int bin = 16 * j + 8 * kt + 2 * g + h;
          atomicAdd((int*)&impsum[r32 * 64 + bin], __float2int_rn(v4 * 16777216.0f));
          if (bin + 1 < 64) atomicAdd((int*)&impsum[r32 * 64 + bin + 1], __float2int_rn(v3 * 16777216.0f));
        }
    }
    __syncthreads();
    for (int tt = 0; tt < 8; ++tt) {
      const int tok = wave * 8 + tt;
      const int jb = lane;
      const bool valid = jb <= cur;
      const bool forced = valid && (jb == 0 || jb == cur || jb == cur - 1);
      const float sc = forced ? INFINITY : (valid ? (float)((const int*)impsum)[tok * 64 + jb] : -INFINITY);
      scr[wave * 64 + lane] = sc;
      __builtin_amdgcn_wave_barrier();
      __builtin_amdgcn_s_waitcnt(0xc07f);
      int rank = 0;
      for (int i = 0; i < 64; ++i) {
        const float o = scr[wave * 64 + i];
        rank += (o > sc || (o == sc && i < jb)) ? 1 : 0;
      }
      const unsigned long long m = __ballot(rank < 16 && valid);
      if (lane == 0) selmask[tok] = m;
      __builtin_amdgcn_wave_barrier();
    }
    __syncthreads();
    msk = selmask[r32];
  } else {
    msk = (2ull << cur) - 1ull;
  }
  flash_init(st);
  {
    SlcMask mg; mg.msk = msk; mg.cur = cur; mg.t = t; mg.jj = 0; mg.sel = false;
    run_branch(L, p.proj + (size_t)b * SEQ * NP + SLOT_KSLC * 64, NP, p.vT_slc + (size_t)b * 64 * SEQ, SEQ, 0, cur + 1, mg, st, tid);
  }
#pragma unroll
  for (int qi = 0; qi < 2; ++qi) {
    const float lt = st.l[qi] + __shfl_xor(st.l[qi], 32);
    const float gs = ldf(gatep + 3 * qi + 1) * (lt > 0.f ? 1.0f / lt : 0.f);
    float* dst = p.mixacc + tokrow * 512 + (2 * wave + qi) * 64;
#pragma unroll
    for (int dt = 0; dt < 2; ++dt)
#pragma unroll
      for (int g = 0; g < 4; ++g) {
        float4* q4 = (float4*)(dst + dt * 32 + 8 * g + 4 * h);
        float4 v = *q4;
        v.x += st.o[qi][dt][4 * g] * gs; v.y += st.o[qi][dt][4 * g + 1] * gs; v.z += st.o[qi][dt][4 * g + 2] * gs; v.w += st.o[qi][dt][4 * g + 3] * gs;
        *q4 = v;
      }
  }
  flash_init(st);
  {
    WinMask mg; mg.t = t; mg.t0 = t0; mg.jj = 0;
    const int jlo = t0 >= 511 ? (t0 - 511) >> 6 : 0;
    run_branch(L, p.proj + (size_t)b * SEQ * NP + SLOT_KWIN * 64, NP, p.vT_win + (size_t)b * 64 * SEQ, SEQ, jlo, cur + 1, mg, st, tid);
  }
#pragma unroll
  for (int qi = 0; qi < 2; ++qi) {
    const float lt = st.l[qi] + __shfl_xor(st.l[qi], 32);
    const float gs = ldf(gatep + 3 * qi + 2) * (lt > 0.f ? 1.0f / lt : 0.f);
    const float* src = p.mixacc + tokrow * 512 + (2 * wave + qi) * 64;
    act_t* dst = p.mix + tokrow * DM + (2 * wave + qi) * 64;
#pragma unroll
    for (int dt = 0; dt < 2; ++dt)
#pragma unroll
      for (int g = 0; g < 4; ++g) {
        const float4 v = *(const float4*)(src + dt * 32 + 8 * g + 4 * h);
        st4(dst + dt * 32 + 8 * g + 4 * h, v.x + st.o[qi][dt][4 * g] * gs, v.y + st.o[qi][dt][4 * g + 1] * gs, v.z + st.o[qi][dt][4 * g + 2] * gs, v.w + st.o[qi][dt][4 * g + 3] * gs);
      }
  }
}

DI void moba_item(const Params& p, unsigned char* smem, int b, int hd, int ob) {
  int tid_ = threadIdx.x;
  asm volatile("" : "+v"(tid_));
  const int tid = tid_, lane = tid & 63, wave = __builtin_amdgcn_readfirstlane(tid >> 6), r32 = lane & 31, h = lane >> 5;
  AttnLds L;
  L.Ks = (bf16_t*)smem; L.Vs = (bf16_t*)(smem + KS_BYTES); L.Qs = (bf16_t*)(smem + KS_BYTES + VS_BYTES + wave * (QS_BYTES / 4));
  float* km = (float*)(smem + KS_BYTES + VS_BYTES + QS_BYTES);
  unsigned* msel = (unsigned*)(km + 16 * 64);
  __syncthreads();
  for (int i = tid; i < 16 * 64; i += NTHREADS) km[i] = p.kmean[(size_t)(b * 8 + hd) * 16 * 64 + i];
  __syncthreads();
  {
    const act_t* qrow = p.proj + ((size_t)b * SEQ + ob * 256 + tid) * NP + (SLOT_MQ + hd) * 64;
    float gsc[16];
#pragma unroll
    for (int n = 0; n < 16; ++n) gsc[n] = 0.f;
    for (int dc = 0; dc < 64; dc += 8) {
      RawA r;
      raw_load(qrow + dc, r);
      float qv[8];
      raw_floats(r, qv);
#pragma unroll
      for (int n = 0; n < 16; ++n) {
        if (n < ob) {
#pragma unroll
          for (int j = 0; j < 8; ++j) gsc[n] += qv[j] * km[n * 64 + dc + j];
        }
      }
    }
    unsigned m = 0;
#pragma unroll
    for (int r = 0; r < 3; ++r) {
      float best = -INFINITY; int bi = -1;
#pragma unroll
      for (int n = 0; n < 16; ++n) {
        const bool ok = (n < ob) && !((m >> n) & 1u);
        if (ok && gsc[n] > best) { best = gsc[n]; bi = n; }
      }
      if (bi >= 0) m |= (1u << bi);
    }
    msel[tid] = m;
  }
  __syncthreads();
  MobaMask mg;
  mg.ob = ob; mg.w = wave; mg.jj = 0; mg.s0 = mg.s1 = false;
#pragma unroll
  for (int qi = 0; qi < 2; ++qi) {
    const int tl = 64 * wave + 32 * qi + r32;
    mg.mq[qi] = msel[tl];
    mg.tpos[qi] = ob * 256 + tl;
    load_q(L, p.proj + ((size_t)b * SEQ + ob * 256 + tl) * NP + (SLOT_MQ + hd) * 64, qi, lane);
  }
  FlashSt st;
  flash_init(st);
  run_branch(L, p.proj + (size_t)b * SEQ * NP + (SLOT_MK + hd) * 64, NP, p.vT_moba + (size_t)(b * 8 + hd) * 64 * SEQ, SEQ, 0, 4 * ob + 4, mg, st, tid);
#pragma unroll
  for (int qi = 0; qi < 2; ++qi) {
    const float lt = st.l[qi] + __shfl_xor(st.l[qi], 32);
    const float inv = lt > 0.f ? 1.0f / lt : 0.f;
    act_t* dst = p.mix + ((size_t)b * SEQ + mg.tpos[qi]) * DM + 512 + hd * 64;
#pragma unroll
    for (int dt = 0; dt < 2; ++dt)
#pragma unroll
      for (int g = 0; g < 4; ++g)
        st4(dst + dt * 32 + 8 * g + 4 * h, st.o[qi][dt][4 * g] * inv, st.o[qi][dt][4 * g + 1] * inv, st.o[qi][dt][4 * g + 2] * inv, st.o[qi][dt][4 * g + 3] * inv);
  }
}

DI void phase3(const Params& p, unsigned char* smem) {
  __shared__ int s_item;
  for (;;) {
    __syncthreads();
    if (threadIdx.x == 0) s_item = atomicAdd(&p.ctr[0], 1);
    __syncthreads();
    const int n = __builtin_amdgcn_readfirstlane(s_item);
    if (n >= 1024) break;
    nsa_item(p, smem, n & 7, 127 - (n >> 3));
  }
  for (;;) {
    __syncthreads();
    if (threadIdx.x == 0) s_item = atomicAdd(&p.ctr[1], 1);
    __syncthreads();
    const int n = __builtin_amdgcn_readfirstlane(s_item);
    if (n >= 1024) break;
    moba_item(p, smem, (n & 63) >> 3, n & 7, 15 - (n >> 6));
  }
}

DI void phase4(const Params& p, unsigned char* smem) {
  const int tid = threadIdx.x, lane = tid & 63, wave = __builtin_amdgcn_readfirstlane(tid >> 6), wm = wave >> 1, wn = wave & 1, r32 = lane & 31, h = lane >> 5;
  for (int tile = blockIdx.x; tile < 256 * 8; tile += gridDim.x) {
    const int mt = tile >> 3, nt = tile & 7, t0 = mt * 128, b = mt >> 5;
    AF_rows<act_t> af; af.src = p.mix + (size_t)t0 * DM; af.ld = DM;
    BF_plain bf; bf.w = p.w_out; bf.ldb = DM; bf.n0 = nt * 128; bf.nmax = DM;
    f32x16 acc[2][2];
    gemm_core<kSplit, 0>(smem, DM, af, bf, acc);
#pragma unroll
    for (int mi = 0; mi < 2; ++mi)
#pragma unroll
      for (int ni = 0; ni < 2; ++ni) {
        const int n = nt * 128 + wn * 64 + ni * 32 + r32;
        const float gt = p.mod[b * 6144 + 2048 + n];
#pragma unroll
        for (int i = 0; i < 16; ++i) {
          const size_t idx = (size_t)(t0 + wm * 64 + mi * 32 + crow(i, h)) * DM + n;
          p.hres[idx] = p.x[idx] + gt * acc[mi][ni][i];
        }
      }
  }
}

DI void phase5a(const Params& p, unsigned char* smem) {
  const int tid = threadIdx.x, lane = tid & 63, wave = __builtin_amdgcn_readfirstlane(tid >> 6), wm = wave >> 1, wn = wave & 1, r32 = lane & 31, h = lane >> 5;
  float* rs = (float*)(smem + GEMM_LDS);
  float* gsv = rs + 128;
  float* shv = gsv + 1024;
  for (int mt = blockIdx.x; mt < 256; mt += gridDim.x) {
    const int t0 = mt * 128, b = mt >> 5;
    __syncthreads();
    for (int i = tid; i < 1024; i += NTHREADS) {
      gsv[i] = p.g_ffn[i] * (1.0f + p.mod[b * 6144 + 4096 + i]);
      shv[i] = p.mod[b * 6144 + 3072 + i];
    }
    __syncthreads();
#pragma unroll 1
    for (int rr = 0; rr < 32; ++rr) {
      const int row = wave * 32 + rr;
      const float* xr = p.hres + (size_t)(t0 + row) * DM;
      float4 xv[4];
      float ss = 0.f;
#pragma unroll
      for (int j = 0; j < 4; ++j) {
        xv[j] = *(const float4*)(xr + lane * 4 + 256 * j);
        ss += xv[j].x * xv[j].x + xv[j].y * xv[j].y + xv[j].z * xv[j].z + xv[j].w * xv[j].w;
      }
      ss = wave_sum(ss);
      const float rsv = 1.0f / sqrtf(ss * (1.0f / DM) + 1e-6f);
      if (lane == 0) rs[row] = rsv;
      act_t* hr = p.h2 + (size_t)(t0 + row) * DM;
#pragma unroll
      for (int j = 0; j < 4; ++j) {
        const int c = lane * 4 + 256 * j;
        st4(hr + c, xv[j].x * rsv * gsv[c] + shv[c], xv[j].y * rsv * gsv[c + 1] + shv[c + 1], xv[j].z * rsv * gsv[c + 2] + shv[c + 2], xv[j].w * rsv * gsv[c + 3] + shv[c + 3]);
      }
    }
    __syncthreads();
#pragma unroll 1
    for (int nt = 0; nt < 2; ++nt) {
      AF_norm_s af; af.src = p.hres + (size_t)t0 * DM; af.rs = rs; af.gsv = gsv; af.shv = shv;
      BF_plain bf; bf.w = p.w_router; bf.ldb = 256; bf.n0 = nt * 128; bf.nmax = 256;
      f32x16 acc[2][2];
      gemm_core<true, 0>(smem, DM, af, bf, acc);
#pragma unroll
      for (int mi = 0; mi < 2; ++mi)
#pragma unroll
        for (int ni = 0; ni < 2; ++ni)
#pragma unroll
          for (int i = 0; i < 16; ++i) {
            const int r = t0 + wm * 64 + mi * 32 + crow(i, h);
            p.scores[(size_t)r * 256 + nt * 128 + wn * 64 + ni * 32 + r32] = sigmoidf_(acc[mi][ni][i]);
          }
    }
  }
#if ORACLE
  {
    float4* ya = (float4*)p.yacc;
    const size_t n4 = (size_t)NT * DM / 4;
    for (size_t i = (size_t)blockIdx.x * NTHREADS + tid; i < n4; i += (size_t)gridDim.x * NTHREADS) ya[i] = make_float4(0, 0, 0, 0);
  }
#endif
}

DI void phase5b(const Params& p) {
  const int tid = threadIdx.x, lane = tid & 63, wave = __builtin_amdgcn_readfirstlane(tid >> 6);
  const int gw = blockIdx.x * 4 + wave, nw = gridDim.x * 4;
  const float4 bias4 = *(const float4*)(p.router_bias + 4 * lane);
  for (int tok = gw; tok < NT; tok += nw) {
    const float4 s4 = *(const float4*)(p.scores + (size_t)tok * 256 + 4 * lane);
    const float sc0 = s4.x, sc1 = s4.y, sc2 = s4.z, sc3 = s4.w;
    const float b0 = sc0 + bias4.x, b1 = sc1 + bias4.y, b2 = sc2 + bias4.z, b3 = sc3 + bias4.w;
    float m1 = fmaxf(b0, b1), m2 = fminf(b0, b1);
    { const float n1 = fmaxf(m1, b2), n2 = fmaxf(fminf(m1, b2), m2); m1 = n1; m2 = n2; }
    { const float n1 = fmaxf(m1, b3), n2 = fmaxf(fminf(m1, b3), m2); m1 = n1; m2 = n2; }
#pragma unroll
    for (int o = 1; o <= 4; o <<= 1) {
      const float o1 = __shfl_xor(m1, o), o2 = __shfl_xor(m2, o);
      const float n1 = fmaxf(m1, o1), n2 = fmaxf(fminf(m1, o1), fmaxf(m2, o2));
      m1 = n1; m2 = n2;
    }
    const float gs = m1 + m2;
    const int g = lane >> 3;
    int rank = 0;
#pragma unroll
    for (int gg = 0; gg < 8; ++gg) {
      const float v = __shfl(gs, gg * 8);
      rank += (v > gs || (v == gs && gg < g)) ? 1 : 0;
    }
    const bool gsel = rank < 4;
    float c0 = gsel ? b0 : -INFINITY, c1 = gsel ? b1 : -INFINITY, c2 = gsel ? b2 : -INFINITY, c3 = gsel ? b3 : -INFINITY;
    int mye = 0; float mys = 0.f, ssum = 0.f;
#pragma unroll 1
    for (int r = 0; r < 8; ++r) {
      float lb = c0; int li = 4 * lane;
      if (c1 > lb) { lb = c1; li = 4 * lane + 1; }
      if (c2 > lb) { lb = c2; li = 4 * lane + 2; }
      if (c3 > lb) { lb = c3; li = 4 * lane + 3; }
#pragma unroll
      for (int o = 32; o >= 1; o >>= 1) {
        const float ov = __shfl_xor(lb, o);
        const int oi = __shfl_xor(li, o);
        if (ov > lb || (ov == lb && oi < li)) { lb = ov; li = oi; }
      }
      const int ol = li >> 2, oj = li & 3;
      const float mine = oj == 0 ? sc0 : (oj == 1 ? sc1 : (oj == 2 ? sc2 : sc3));
      const float ws = __shfl(mine, ol);
      if (lane == ol) {
        if (oj == 0) c0 = -INFINITY; else if (oj == 1) c1 = -INFINITY; else if (oj == 2) c2 = -INFINITY; else c3 = -INFINITY;
      }
      ssum += ws;
      if (lane == r) { mye = li; mys = ws; }
    }
    if (lane < 8) {
      const float w = mys / ssum * 2.5f;
      const int rk = atomicAdd(&p.cnt[mye], 1);
      p.list[(size_t)mye * CAP + rk] = tok * NSLOT + lane;
      p.selw[tok * NSLOT + lane] = w;
    }
  }
}

struct AF_gather {
  typedef typename RawOf<act_t>::type Raw;
  const act_t* h2; const int* rowtok;
  DI void load(int row, int k, Raw& r) const {
    const int tk = max(rowtok[row], 0);
    raw_load(h2 + (size_t)tk * DM + k, r);
  }
  DI void cvt(const Raw& r, int row, int k, bf16x8& hi, bf16x8& lo) const { raw_frag<kSplit>(r, hi, lo); }
};
struct BF_gateup {
  const float *wg, *wu; int c0;
  DI float load(int k, int n) const { return n < 64 ? wg[(size_t)k * 256 + c0 + n] : wu[(size_t)k * 256 + c0 + n - 64]; }
};

DI void phase6(const Params& p, unsigned char* smem) {
  const int tid = threadIdx.x, lane = tid & 63, wave = __builtin_amdgcn_readfirstlane(tid >> 6), wm = wave >> 1, wn = wave & 1, r32 = lane & 31, h = lane >> 5;
  int* pre = (int*)(smem + GEMM_LDS);
  int* rowslot = pre + 260;
  int* rowtok = rowslot + 128;
  float* roww = (float*)(rowtok + 128);
  __syncthreads();
  if (tid == 0) {
    int s = 0;
    for (int e = 0; e < NEXP; ++e) { pre[e] = s; s += (p.cnt[e] + 127) >> 7; }
    pre[NEXP] = s; s += 256; pre[NEXP + 1] = s;
  }
  __syncthreads();
  const int total = __builtin_amdgcn_readfirstlane(pre[NEXP + 1]);
  act_t* ab = p.abuf + (size_t)blockIdx.x * 128 * 256;
  for (int item = blockIdx.x; item < total; item += gridDim.x) {
    int lo = 0, hi = NEXP;
    while (lo < hi) { const int mid = (lo + hi + 1) >> 1; if (pre[mid] <= item) lo = mid; else hi = mid - 1; }
    const int e = __builtin_amdgcn_readfirstlane(lo), mt = __builtin_amdgcn_readfirstlane(item - pre[lo]);
    __syncthreads();
    if (tid < 128) {
      int slot = -1; float w = 0.f;
      if (e < NEXP) {
        const int idx = mt * 128 + tid;
        if (idx < p.cnt[e]) { slot = p.list[(size_t)e * CAP + idx]; w = p.selw[slot]; }
      } else {
        slot = (mt * 128 + tid) * NSLOT + 8; w = 1.0f;
      }
      rowslot[tid] = slot; rowtok[tid] = slot >= 0 ? slot / NSLOT : -1; roww[tid] = w;
    }
    __syncthreads();
    const float* wg = e < NEXP ? p.w_eg + (size_t)e * DM * 256 : p.w_sg;
    const float* wu = e < NEXP ? p.w_eu + (size_t)e * DM * 256 : p.w_su;
    const float* wd = e < NEXP ? p.w_ed + (size_t)e * 256 * DM : p.w_sd;
#pragma unroll 1
    for (int nt = 0; nt < 4; ++nt) {
      AF_gather af; af.h2 = p.h2; af.rowtok = rowtok;
      BF_gateup bf; bf.wg = wg; bf.wu = wu; bf.c0 = nt * 64;
      f32x16 acc[2][2];
      gemm_core<kSplit, 1>(smem, DM, af, bf, acc);
#pragma unroll
      for (int mi = 0; mi < 2; ++mi)
#pragma unroll
        for (int i = 0; i < 16; ++i) {
          const int r = wm * 64 + mi * 32 + crow(i, h);
          const int cc = nt * 64 + wn * 32 + r32;
          st1(ab + (size_t)r * 256 + cc, siluf_(acc[mi][0][i]) * acc[mi][1][i]);
        }
    }
    __threadfence_block();
    __syncthreads();
#pragma unroll 1
    for (int nt = 0; nt < 8; ++nt) {
      AF_rows<act_t> af; af.src = ab; af.ld = 256;
      BF_plain bf; bf.w = wd; bf.ldb = DM; bf.n0 = nt * 128; bf.nmax = DM;
      f32x16 acc[2][2];
      gemm_core<kSplit, 0>(smem, 256, af, bf, acc);
#pragma unroll
      for (int mi = 0; mi < 2; ++mi)
#pragma unroll
        for (int i = 0; i < 16; ++i) {
          const int r = wm * 64 + mi * 32 + crow(i, h);
          const int slot = rowslot[r];
          if (slot >= 0) {
            const float w = roww[r];
#pragma unroll
            for (int ni = 0; ni < 2; ++ni) {
              const int n = nt * 128 + wn * 64 + ni * 32 + r32;
#if ORACLE
              atomicAdd((int*)&p.yacc[(size_t)rowtok[r] * DM + n], __float2int_rn(acc[mi][ni][i] * w * 16777216.0f));
#else
              st1(p.yslots + (size_t)slot * DM + n, acc[mi][ni][i] * w);
#endif
            }
          }
        }
    }
  }
}

DI void phase7(const Params& p) {
  const int tid = threadIdx.x, lane = tid & 63, wave = __builtin_amdgcn_readfirstlane(tid >> 6);
  const int gw = blockIdx.x * 4 + wave, nw = gridDim.x * 4;
  for (int tok = gw; tok < NT; tok += nw) {
    const int b = tok >> 12;
    float v[16];
    float ss = 0.f;
#pragma unroll
    for (int j = 0; j < 4; ++j) {
      const int col = lane * 4 + 256 * j;
      const float4 hr = *(const float4*)(p.hres + (size_t)tok * DM + col);
      float y[4] = {0.f, 0.f, 0.f, 0.f};
#if ORACLE
      {
        const int4 yi = *(const int4*)(p.yacc + (size_t)tok * DM + col);
        y[0] = (float)yi.x * (1.0f / 16777216.0f); y[1] = (float)yi.y * (1.0f / 16777216.0f); y[2] = (float)yi.z * (1.0f / 16777216.0f); y[3] = (float)yi.w * (1.0f / 16777216.0f);
      }
#else
#pragma unroll
      for (int k = 0; k < NSLOT; ++k) {
        float t4[4];
        ld4f(p.yslots + ((size_t)tok * NSLOT + k) * DM + col, t4);
        y[0] += t4[0]; y[1] += t4[1]; y[2] += t4[2]; y[3] += t4[3];
      }
#endif
      const float4 gt = *(const float4*)(p.mod + b * 6144 + 5120 + col);
      v[4 * j] = hr.x + gt.x * y[0]; v[4 * j + 1] = hr.y + gt.y * y[1]; v[4 * j + 2] = hr.z + gt.z * y[2]; v[4 * j + 3] = hr.w + gt.w * y[3];
      ss += v[4 * j] * v[4 * j] + v[4 * j + 1] * v[4 * j + 1] + v[4 * j + 2] * v[4 * j + 2] + v[4 * j + 3] * v[4 * j + 3];
    }
    ss = wave_sum(ss);
    const float r = 1.0f / sqrtf(ss * (1.0f / DM) + 1e-6f);
#pragma unroll
    for (int j = 0; j < 4; ++j) {
      const int col = lane * 4 + 256 * j;
      const float4 g = *(const float4*)(p.g_final + col);
      *(float4*)(p.out + (size_t)tok * DM + col) = make_float4(v[4 * j] * r * g.x, v[4 * j + 1] * r * g.y, v[4 * j + 2] * r * g.z, v[4 * j + 3] * r * g.w);
    }
  }
}

DI void gsync(cg::grid_group& grid) {
  asm volatile("s_waitcnt vmcnt(0)" ::: "memory");
  __syncthreads();
  __builtin_amdgcn_fence(__ATOMIC_RELEASE, "agent");
  asm volatile("s_waitcnt vmcnt(0)" ::: "memory");
  grid.sync();
  __builtin_amdgcn_fence(__ATOMIC_ACQUIRE, "agent");
  asm volatile("s_waitcnt vmcnt(0)" ::: "memory");
  __syncthreads();
}

DI void dbg_dump(const Params& p, int which) {
  const size_t n = (size_t)NT * DM;
  for (size_t i = (size_t)blockIdx.x * NTHREADS + threadIdx.x; i < n; i += (size_t)gridDim.x * NTHREADS) {
    const size_t t = i >> 10; const int c = (int)(i & 1023);
    float v = 0.f;
    if (which == 1) {
      int col;
      if (c < 704) col = c; else if (c < 768) col = 768 + (c - 704); else if (c < 792) col = 896 + (c - 768); else col = 960 + (c - 792);
      v = ldf(p.proj + t * NP + col);
    } else if (which == 12) {
      int col;
      if (c < 64) col = SLOT_VSLC * 64 + c; else if (c < 128) col = SLOT_VWIN * 64 + (c - 64); else if (c < 640) col = SLOT_MV * 64 + (c - 128); else col = -1;
      if (col >= 0) v = ldf(p.proj + t * NP + col);
    } else if (which == 11) {
      const size_t per = (size_t)8 * 64 * SEQ;
      const act_t* q_ = nullptr;
      if (i < per) q_ = p.vT_slc + i; else if (i < 2 * per) q_ = p.vT_win + (i - per); else if (i < 10 * per) q_ = p.vT_moba + (i - 2 * per);
      if (q_) { act_t raw_ = __hip_atomic_load(q_, __ATOMIC_RELAXED, __HIP_MEMORY_SCOPE_SYSTEM); v = ldf(&raw_); }
    } else if (which == 2) {
      if (i < 8 * 256 * 64) { if (((i >> 6) & 255) != 255) v = ldf(p.kc + i); }
      else if (i < 2 * 8 * 256 * 64) { const size_t k = i - 8 * 256 * 64; if ((k & 255) != 255) v = ldf(p.vcT + k); }
      else if (i < 2 * 8 * 256 * 64 + 8 * 8 * 16 * 64) v = p.kmean[i - 2 * 8 * 256 * 64];
    } else if (which == 3) {
      v = ldf(p.mix + i);
    } else if (which == 4) {
      v = p.hres[i];
    } else if (which == 5) {
      v = ldf(p.h2 + i);
    }
    p.out[i] = v;
  }
}

__global__ void __launch_bounds__(NTHREADS, ORACLE ? 1 : 2) fwd_megakernel(Params p) {
  __shared__ __attribute__((aligned(16))) unsigned char smem[SMEM_BYTES];
  cg::grid_group grid = cg::this_grid();
  phase0(p, smem);
  gsync(grid);
  phase1(p, smem);
  gsync(grid);
  if (DBG == 1 || DBG == 11 || DBG == 12) { dbg_dump(p, DBG); return; }
  phase2a(p, smem);
  gsync(grid);
  phase2b(p, smem);
  gsync(grid);
  if (DBG == 2) { dbg_dump(p, DBG); return; }
  phase3(p, smem);
  gsync(grid);
  if (DBG == 3) { dbg_dump(p, DBG); return; }
  phase4(p, smem);
  gsync(grid);
  if (DBG == 4) { dbg_dump(p, DBG); return; }
  phase5a(p, smem);
  gsync(grid);
  if (DBG == 5) { dbg_dump(p, DBG); return; }
  phase5b(p);
  gsync(grid);
  phase6(p, smem);
  gsync(grid);
  phase7(p);
}

static size_t align_up(size_t v) { return (v + 255) & ~(size_t)255; }

extern "C" void kernel_launch(void* const* d_in, const int* in_sizes, int n_in, void* d_out, int out_size, void* d_ws, size_t ws_size,
                              hipStream_t stream) {
  static int grid_blocks = 0;
  if (!grid_blocks) {
    int dev = 0, cus = 0, per_cu = 0;
    hipGetDevice(&dev);
    hipDeviceGetAttribute(&cus, hipDeviceAttributeMultiprocessorCount, dev);
    hipOccupancyMaxActiveBlocksPerMultiprocessor(&per_cu, fwd_megakernel, NTHREADS, 0);
    if (per_cu > 2) per_cu = 2;
    if (per_cu < 1) per_cu = 1;
    grid_blocks = cus * per_cu;
  }
  Params p{};
  const float* const* in = (const float* const*)d_in;
  p.x = in[0]; p.c = in[1]; p.w_ada = in[2]; p.b_ada = in[3]; p.g_attn = in[4]; p.w_in = in[5];
  p.pos_k = in[6]; p.w1_k = in[7]; p.w2_k = in[8]; p.pos_v = in[9]; p.w1_v = in[10]; p.w2_v = in[11];
  p.w_out = in[12]; p.g_ffn = in[13]; p.w_router = in[14]; p.router_bias = in[15];
  p.w_eg = in[16]; p.w_eu = in[17]; p.w_ed = in[18]; p.w_sg = in[19]; p.w_su = in[20]; p.w_sd = in[21]; p.g_final = in[22];
  p.out = (float*)d_out;
  unsigned char* ws = (unsigned char*)d_ws;
  size_t off = 0;
  auto take = [&](size_t bytes) { unsigned char* q = ws + off; off = align_up(off + bytes); return q; };
  p.mod = (float*)take(8 * 6144 * 4);
  p.ropec = (float*)take(4096 * 32 * 4);
  p.ropes = (float*)take(4096 * 32 * 4);
  p.rstd1 = (float*)take((size_t)NT * 4);
  p.kmean = (float*)take(8 * 8 * 16 * 64 * 4);
  p.cnt = (int*)take(1024 * 4);
  p.ctr = (int*)take(256);
  p.selw = (float*)take((size_t)NT * NSLOT * 4);
  p.scores = (float*)take((size_t)NT * 256 * 4);
  p.hres = (float*)take((size_t)NT * DM * 4);
  p.h2 = (act_t*)take((size_t)NT * DM * sizeof(act_t));
  p.list = (int*)take((size_t)NEXP * CAP * 4);
  const size_t uoff = off;
  p.proj = (act_t*)take((size_t)(NT + 64) * NP * sizeof(act_t));
  p.vT_slc = (act_t*)take((size_t)80 * 64 * SEQ * sizeof(act_t));
  p.vT_win = p.vT_slc + (size_t)8 * 64 * SEQ;
  p.vT_moba = p.vT_slc + (size_t)16 * 64 * SEQ;
  p.hid = (act_t*)take((size_t)2 * 2048 * 256 * sizeof(act_t));
  p.kc = (act_t*)take((size_t)8 * 256 * 64 * sizeof(act_t));
  p.vcT = (act_t*)take((size_t)8 * 64 * 256 * sizeof(act_t));
  p.mixacc = (float*)take((size_t)NT * 512 * 4);
  p.mix = (act_t*)take((size_t)NT * DM * sizeof(act_t));
  const size_t end_a = off;
  off = uoff;
  p.abuf = (act_t*)take((size_t)grid_blocks * 128 * 256 * sizeof(act_t));
#if ORACLE
  p.yacc = (float*)take((size_t)NT * DM * 4);
  p.yslots = nullptr;
#else
  p.yacc = nullptr;
  p.yslots = (act_t*)take((size_t)NT * NSLOT * DM * sizeof(act_t));
#endif
  const size_t end_b = off;
  const size_t need = end_a > end_b ? end_a : end_b;
  if (need > ws_size) { fprintf(stderr, "kernel_launch: workspace too small: need %zu have %zu\n", need, ws_size); return; }
  void* args[] = {&p};
  hipError_t e = hipLaunchCooperativeKernel((void*)fwd_megakernel, dim3(grid_blocks), dim3(NTHREADS), args, 0, stream);
  if (e != hipSuccess) fprintf(stderr, "cooperative launch failed: %s (grid %d)\n", hipGetErrorString(e), grid_blocks);
}
```

```cpp
#include <hip/hip_runtime.h>
#include <hip/hip_cooperative_groups.h>
#include <cstdio>
#include <cstdint>
namespace cg = cooperative_groups;

#ifndef ORACLE
#define ORACLE 0
#endif
#ifndef DBG
#define DBG 0
#endif
#define DI __device__ __forceinline__

typedef unsigned short bf16_t;
typedef __attribute__((ext_vector_type(8))) short bf16x8;
typedef __attribute__((ext_vector_type(4))) short s16x4;
typedef __attribute__((ext_vector_type(16))) float f32x16;
typedef __attribute__((ext_vector_type(4))) unsigned int u32x4;

#if ORACLE
typedef float act_t;
constexpr bool kSplit = true;
#else
typedef bf16_t act_t;
constexpr bool kSplit = false;
#endif

constexpr int DM = 1024, NB = 8, SEQ = 4096, NT = NB * SEQ;
constexpr int INC = 2456;
constexpr int NP = 2496;
constexpr int SLOT_KCMP = 8, SLOT_VCMP = 9, SLOT_KSLC = 10, SLOT_VSLC = 11, SLOT_KWIN = 12, SLOT_VWIN = 13, SLOT_GATE = 14;
constexpr int SLOT_MQ = 15, SLOT_MK = 23, SLOT_MV = 31;
constexpr int NEXP = 256, CAP = 32768, NSLOT = 9;
constexpr int SMEM_BYTES = 77 * 1024;
constexpr int NTHREADS = 256;
constexpr float QSCALE = 0.125f * 1.44269504088896340736f;
constexpr int CNT_STRIDE = 64;
constexpr int LDH = 1056;

struct Params {
  const float *x, *c, *w_ada, *b_ada, *g_attn, *w_in, *pos_k, *w1_k, *w2_k, *pos_v, *w1_v, *w2_v, *w_out, *g_ffn,
      *w_router, *router_bias, *w_eg, *w_eu, *w_ed, *w_sg, *w_su, *w_sd, *g_final;
  float* out;
  float *mod, *ropec, *ropes, *kmean, *mixacc, *hres, *scores, *selw, *yacc, *hidp;
  act_t *proj, *vT_slc, *vT_win, *vT_moba, *hid, *kc, *vcT, *mix, *h2, *abuf, *yslots, *h1;
  bf16_t *h2lo;
  bf16_t *winT, *winTl, *woutT, *woutTl, *wrT, *wrTl, *w1kT, *w1kTl, *w1vT, *w1vTl, *w2kT, *w2kTl, *w2vT, *w2vTl;
  int *cnt, *list, *ctr;
  unsigned* bar;
};

DI int otid() { int t = threadIdx.x; asm volatile("" : "+v"(t)); return t; }
typedef float f32x4 __attribute__((ext_vector_type(4)));
DI f32x4 make_f32x4(float a, float b, float c, float d) { f32x4 v = {a, b, c, d}; return v; }
DI bf16_t f2bf(float x) { __bf16 b = (__bf16)x; return __builtin_bit_cast(bf16_t, b); }
DI float bf2f(bf16_t h) { return __uint_as_float(((unsigned)h) << 16); }
DI float sigmoidf_(float x) { return 1.0f / (1.0f + __expf(-x)); }
DI float siluf_(float x) { return x / (1.0f + __expf(-x)); }
DI float sigmoidf_fast(float x) { return __builtin_amdgcn_rcpf(1.0f + __expf(-x)); }
DI float siluf_fast(float x) { return x * __builtin_amdgcn_rcpf(1.0f + __expf(-x)); }
DI int crow(int i, int h) { return (i & 3) + 8 * (i >> 2) + 4 * h; }
#define MFMA(a, b, c) __builtin_amdgcn_mfma_f32_32x32x16_bf16((a), (b), (c), 0, 0, 0)

struct RawF { float4 a, b; };
struct RawH { uint4 u; };
template <class T> struct RawOf;
template <> struct RawOf<float> { typedef RawF type; };
template <> struct RawOf<bf16_t> { typedef RawH type; };

DI void raw_load(const float* p, RawF& r) { r.a = *(const float4*)p; r.b = *(const float4*)(p + 4); }
DI void raw_load(const bf16_t* p, RawH& r) { r.u = *(const uint4*)p; }
DI void raw_zero(RawF& r) { r.a = make_float4(0, 0, 0, 0); r.b = r.a; }
DI void raw_zero(RawH& r) { r.u = make_uint4(0, 0, 0, 0); }
DI void raw_floats(const RawF& r, float (&v)[8]) { v[0] = r.a.x; v[1] = r.a.y; v[2] = r.a.z; v[3] = r.a.w; v[4] = r.b.x; v[5] = r.b.y; v[6] = r.b.z; v[7] = r.b.w; }
DI void raw_floats(const RawH& r, float (&v)[8]) {
  v[0] = __uint_as_float(r.u.x << 16); v[1] = __uint_as_float(r.u.x & 0xffff0000u);
  v[2] = __uint_as_float(r.u.y << 16); v[3] = __uint_as_float(r.u.y & 0xffff0000u);
  v[4] = __uint_as_float(r.u.z << 16); v[5] = __uint_as_float(r.u.z & 0xffff0000u);
  v[6] = __uint_as_float(r.u.w << 16); v[7] = __uint_as_float(r.u.w & 0xffff0000u);
}
template <bool SPLIT> DI void cvt8(const float (&v)[8], bf16x8& hi, bf16x8& lo) {
#pragma unroll
  for (int j = 0; j < 8; ++j) {
    bf16_t hh = f2bf(v[j]);
    hi[j] = (short)hh;
    if (SPLIT) lo[j] = (short)f2bf(v[j] - bf2f(hh)); else lo[j] = 0;
  }
}
template <bool SPLIT> DI void raw_frag(const RawF& r, bf16x8& hi, bf16x8& lo) { float v[8]; raw_floats(r, v); cvt8<SPLIT>(v, hi, lo); }
template <bool SPLIT> DI void raw_frag(const RawH& r, bf16x8& hi, bf16x8& lo) { hi = __builtin_bit_cast(bf16x8, r.u); lo = bf16x8{0, 0, 0, 0, 0, 0, 0, 0}; }

DI void st1(float* p, float v) { *p = v; }
DI void st1(bf16_t* p, float v) { *p = f2bf(v); }
DI void st4(float* p, float a, float b, float c, float d) { *(float4*)p = make_float4(a, b, c, d); }
DI void st4(bf16_t* p, float a, float b, float c, float d) {
  uint2 u;
  u.x = (unsigned)f2bf(a) | ((unsigned)f2bf(b) << 16);
  u.y = (unsigned)f2bf(c) | ((unsigned)f2bf(d) << 16);
  *(uint2*)p = u;
}
DI void st8(float* p, const float (&v)[8]) { *(float4*)p = make_float4(v[0], v[1], v[2], v[3]); *(float4*)(p + 4) = make_float4(v[4], v[5], v[6], v[7]); }
DI void st8(bf16_t* p, const float (&v)[8]) {
  uint4 u;
  u.x = (unsigned)f2bf(v[0]) | ((unsigned)f2bf(v[1]) << 16);
  u.y = (unsigned)f2bf(v[2]) | ((unsigned)f2bf(v[3]) << 16);
  u.z = (unsigned)f2bf(v[4]) | ((unsigned)f2bf(v[5]) << 16);
  u.w = (unsigned)f2bf(v[6]) | ((unsigned)f2bf(v[7]) << 16);
  *(uint4*)p = u;
}
DI float ldf(const float* p) { return *p; }
DI float ldf(const bf16_t* p) { return bf2f(*p); }
DI void ld4f(const float* p, float (&v)[4]) { float4 a = *(const float4*)p; v[0] = a.x; v[1] = a.y; v[2] = a.z; v[3] = a.w; }
DI void ld4f(const bf16_t* p, float (&v)[4]) {
  uint2 u = *(const uint2*)p;
  v[0] = __uint_as_float(u.x << 16); v[1] = __uint_as_float(u.x & 0xffff0000u);
  v[2] = __uint_as_float(u.y << 16); v[3] = __uint_as_float(u.y & 0xffff0000u);
}
DI unsigned pack2bf(float a, float b) { return (unsigned)f2bf(a) | ((unsigned)f2bf(b) << 16); }
DI void st8bf(bf16_t* p, const float (&v)[8]) {
  u32x4 u;
#pragma unroll
  for (int q = 0; q < 4; ++q) u[q] = pack2bf(v[2 * q], v[2 * q + 1]);
  *(u32x4*)p = u;
}
template <int CTRL> DI float dppf(float v) { return __int_as_float(__builtin_amdgcn_update_dpp(__float_as_int(v), __float_as_int(v), CTRL, 0xf, 0xf, false)); }
DI float rlf(float v, int l) { return __int_as_float(__builtin_amdgcn_readlane(__float_as_int(v), l)); }
constexpr int DPP_XOR1 = 0xB1, DPP_XOR2 = 0x4E, DPP_HMIRROR = 0x141, DPP_MIRROR = 0x140;
DI float wave_sum(float v) {
  v += dppf<DPP_XOR1>(v); v += dppf<DPP_XOR2>(v); v += dppf<DPP_HMIRROR>(v); v += dppf<DPP_MIRROR>(v);
  return (rlf(v, 0) + rlf(v, 16)) + (rlf(v, 32) + rlf(v, 48));
}
DI float pair_max32(float v) {
  const auto r = __builtin_amdgcn_permlane32_swap(__float_as_uint(v), __float_as_uint(v), false, false);
  return fmaxf(__uint_as_float(r[0]), __uint_as_float(r[1]));
}
DI float pair_sum32(float v) {
  const auto r = __builtin_amdgcn_permlane32_swap(__float_as_uint(v), __float_as_uint(v), false, false);
  return __uint_as_float(r[0]) + __uint_as_float(r[1]);
}
DI void st_pair16(bf16_t* dst_g, int h, float a0, float a1, float a2, float a3, float b0, float b1, float b2, float b3) {
  const unsigned ax = pack2bf(a0, a1), ay = pack2bf(a2, a3), bx = pack2bf(b0, b1), by = pack2bf(b2, b3);
  const auto rx = __builtin_amdgcn_permlane32_swap(ax, bx, false, false);
  const auto ry = __builtin_amdgcn_permlane32_swap(ay, by, false, false);
  u32x4 v; v[0] = rx[0]; v[1] = ry[0]; v[2] = rx[1]; v[3] = ry[1];
  *(u32x4*)(dst_g + 8 * h) = v;
}


#define XB_TMO      128
#define XB_XCNT(j)  (256  + 64 * (j))
#define XB_XSUB(j)  (1280 + 64 * (j))
#define XB_XGEN(j)  (2304 + 64 * (j))
#define XB_TOP      3328
#define XB_TOPGEN   3392
#define XCD_BAR_WORDS 3456
#define XB_SPIN_CAP (1u << 20)
#define LAS __attribute__((address_space(3)))
DI unsigned xb_ld(unsigned* p) { return __hip_atomic_load(p, __ATOMIC_RELAXED, __HIP_MEMORY_SCOPE_AGENT); }
DI unsigned xb_add(unsigned* p, unsigned v) { return __hip_atomic_fetch_add(p, v, __ATOMIC_RELAXED, __HIP_MEMORY_SCOPE_AGENT); }
DI unsigned xb_xcc_id() { return (unsigned)__builtin_amdgcn_s_getreg((3 << 11) | 20) & 0xFu; }
#define XB_SPIN(cond, bar) do { unsigned _sp = 0; while (cond) { __builtin_amdgcn_s_sleep(1); \
    if ((++_sp & 255u) == 0u) { if (xb_ld(&(bar)[XB_TMO])) break; if (_sp > XB_SPIN_CAP) { atomicAdd(&(bar)[XB_TMO], 1u); break; } } } } while (0)
struct XcdBarrier { unsigned* bar; unsigned x; volatile LAS unsigned* st; };
DI XcdBarrier xcd_barrier_post(unsigned* bar, volatile LAS unsigned* st) {
  XcdBarrier b; b.bar = bar; b.x = xb_xcc_id(); b.st = st;
  if (threadIdx.x == 0) (void)xb_add(&bar[XB_XCNT(b.x)], 1u);
  return b;
}
DI void xcd_barrier_complete(unsigned* bar, unsigned x, unsigned& nloc, unsigned& nx) {
  const unsigned G = gridDim.x * gridDim.y * gridDim.z;
  unsigned sum, cnt, mine, sp = 0u;
  for (;;) {
    sum = 0u; cnt = 0u; mine = 0u;
#pragma unroll
    for (unsigned j = 0; j < 16; ++j) { const unsigned c = xb_ld(&bar[XB_XCNT(j)]); sum += c; cnt += (c > 0u) ? 1u : 0u; mine = (j == x) ? c : mine; }
    if (sum == G) break;
    __builtin_amdgcn_s_sleep(1);
    if ((++sp & 255u) == 0u) { if (xb_ld(&bar[XB_TMO])) break; if (sp > XB_SPIN_CAP) { atomicAdd(&bar[XB_TMO], 1u); break; } }
  }
  nloc = mine > 0u ? mine : 1u; nx = cnt > 0u ? cnt : 1u;
}
DI void xcd_barrier(const XcdBarrier& b) {
  asm volatile("s_waitcnt vmcnt(0)" ::: "memory");
  __syncthreads();
  if (threadIdx.x == 0) {
    unsigned* bar = b.bar;
    __builtin_amdgcn_s_waitcnt(0);
    unsigned nloc = b.st[0], nx = b.st[1];
    if (nloc == 0u) { xcd_barrier_complete(bar, b.x, nloc, nx); b.st[0] = nloc; b.st[1] = nx; }
    const unsigned old = xb_add(&bar[XB_XSUB(b.x)], 1u);
    const unsigned gen = old / nloc;
    if (old + 1u == (gen + 1u) * nloc) {
      __builtin_amdgcn_fence(__ATOMIC_RELEASE, "agent");
      asm volatile("s_waitcnt vmcnt(0)" ::: "memory");
      const unsigned og = xb_add(&bar[XB_TOP], 1u);
      const unsigned tg = og / nx;
      if (og + 1u == (tg + 1u) * nx) xb_add(&bar[XB_TOPGEN], 1u);
      else XB_SPIN(xb_ld(&bar[XB_TOPGEN]) == tg, bar);
      __builtin_amdgcn_fence(__ATOMIC_ACQUIRE, "agent");
      xb_add(&bar[XB_XGEN(b.x)], 1u);
      asm volatile("s_waitcnt vmcnt(0)" ::: "memory");
    } else {
      XB_SPIN(xb_ld(&bar[XB_XGEN(b.x)]) == gen, bar);
      __builtin_amdgcn_fence(__ATOMIC_ACQUIRE, "agent");
      asm volatile("s_waitcnt vmcnt(0)" ::: "memory");
    }
  }
  __syncthreads();
}

constexpr int LDA_S = 40;
constexpr int GEMM_STAGE = 2 * 128 * LDA_S * 2;
constexpr int GEMM_LDS = 2 * GEMM_STAGE;

struct BT16 {
  struct Raw { u32x4 r0, r1, l0, l1; };
  const bf16_t* w; const bf16_t* wlo; int ldk; int n0;
  template <bool SPLIT> DI void load(int k0, int tid, Raw& q) const {
    const size_t o = (size_t)(n0 + (tid >> 2)) * ldk + k0 + (tid & 3) * 8;
    const size_t o2 = o + (size_t)64 * ldk;
    q.r0 = *(const u32x4*)(w + o); q.r1 = *(const u32x4*)(w + o2);
    if (SPLIT) { q.l0 = *(const u32x4*)(wlo + o); q.l1 = *(const u32x4*)(wlo + o2); } else { q.l0 = q.r0; q.l1 = q.r1; }
  }
  template <bool SPLIT> DI void store(bf16_t* Bs, bf16_t* Bsl, int tid, const Raw& q) const {
    const int o = (tid >> 2) * LDA_S + (tid & 3) * 8;
    *(u32x4*)&Bs[o] = q.r0; *(u32x4*)&Bs[o + 64 * LDA_S] = q.r1;
    if (SPLIT) { *(u32x4*)&Bsl[o] = q.l0; *(u32x4*)&Bsl[o + 64 * LDA_S] = q.l1; }
  }
};
struct BF32 {
  struct Raw { float2 r[8]; };
  const float* wa; const float* wb; int ldb; int ca; int cb;
  template <bool SPLIT> DI void load(int k0, int tid, Raw& q) const {
    const int np = tid & 63, kk = tid >> 6;
    const float* base = (np < 32) ? (wa + ca + 2 * np) : (wb + cb + 2 * (np - 32));
    base += (size_t)(k0 + 8 * kk) * ldb;
#pragma unroll
    for (int j = 0; j < 8; ++j) q.r[j] = *(const float2*)(base + (size_t)j * ldb);
  }
  template <bool SPLIT> DI void store(bf16_t* Bs, bf16_t* Bsl, int tid, const Raw& q) const {
    const int np = tid & 63, kk = tid >> 6;
    float v0[8], v1[8];
#pragma unroll
    for (int j = 0; j < 8; ++j) { v0[j] = q.r[j].x; v1[j] = q.r[j].y; }
    bf16x8 hi, lo;
    cvt8<SPLIT>(v0, hi, lo);
    *(bf16x8*)&Bs[(2 * np) * LDA_S + 8 * kk] = hi;
    if (SPLIT) *(bf16x8*)&Bsl[(2 * np) * LDA_S + 8 * kk] = lo;
    cvt8<SPLIT>(v1, hi, lo);
    *(bf16x8*)&Bs[(2 * np + 1) * LDA_S + 8 * kk] = hi;
    if (SPLIT) *(bf16x8*)&Bsl[(2 * np + 1) * LDA_S + 8 * kk] = lo;
  }
};

template <bool SPLIT, class AF, class BP>
DI void gemm_stage_store(unsigned char* smem, int st, int k0, const AF& af, const BP& bp, const typename AF::Raw& ra0, const typename AF::Raw& ra1,
                         const typename BP::Raw& rb, int tid) {
  bf16_t* As = (bf16_t*)(smem + (SPLIT ? 0 : st * GEMM_STAGE));
  bf16_t* Bs = As + 128 * LDA_S;
  bf16_t* Asl = Bs + 128 * LDA_S;
  bf16_t* Bsl = Asl + 128 * LDA_S;
  const int arow0 = tid >> 2, akc = (tid & 3) * 8;
  bf16x8 hi, lo;
  af.cvt(ra0, arow0, k0 + akc, hi, lo);
  *(bf16x8*)&As[arow0 * LDA_S + akc] = hi;
  if (SPLIT) *(bf16x8*)&Asl[arow0 * LDA_S + akc] = lo;
  af.cvt(ra1, arow0 + 64, k0 + akc, hi, lo);
  *(bf16x8*)&As[(arow0 + 64) * LDA_S + akc] = hi;
  if (SPLIT) *(bf16x8*)&Asl[(arow0 + 64) * LDA_S + akc] = lo;
  bp.template store<SPLIT>(Bs, Bsl, tid, rb);
}
template <bool SPLIT, int NMAP>
DI void gemm_compute(const unsigned char* smem, int st, f32x16 (&acc)[2][2], int wm, int wn, int r32, int h) {
  const bf16_t* As = (const bf16_t*)(smem + (SPLIT ? 0 : st * GEMM_STAGE));
  const bf16_t* Bs = As + 128 * LDA_S;
  const bf16_t* Asl = Bs + 128 * LDA_S;
  const bf16_t* Bsl = Asl + 128 * LDA_S;
  if (!SPLIT) {
    bf16x8 a[2][2], b[2][2];
#pragma unroll
    for (int ks = 0; ks < 2; ++ks) {
#pragma unroll
      for (int mi = 0; mi < 2; ++mi) a[ks][mi] = *(const bf16x8*)&As[(wm * 64 + mi * 32 + r32) * LDA_S + ks * 16 + h * 8];
#pragma unroll
      for (int ni = 0; ni < 2; ++ni) {
        const int nrow = (NMAP == 0) ? (wn * 64 + ni * 32) : (ni == 0 ? wn * 32 : 64 + wn * 32);
        b[ks][ni] = *(const bf16x8*)&Bs[(nrow + r32) * LDA_S + ks * 16 + h * 8];
      }
    }
    asm volatile("s_waitcnt lgkmcnt(0)" ::: "memory");
    __builtin_amdgcn_sched_barrier(0);
    __builtin_amdgcn_s_setprio(1);
#pragma unroll
    for (int ks = 0; ks < 2; ++ks)
#pragma unroll
      for (int ni = 0; ni < 2; ++ni)
#pragma unroll
        for (int mi = 0; mi < 2; ++mi) acc[mi][ni] = MFMA(a[ks][mi], b[ks][ni], acc[mi][ni]);
    __builtin_amdgcn_s_setprio(0);
    __builtin_amdgcn_sched_barrier(0);
    return;
  }
#pragma unroll
  for (int ks = 0; ks < 2; ++ks) {
    bf16x8 a[2], al[2];
#pragma unroll
    for (int mi = 0; mi < 2; ++mi) {
      const int off = (wm * 64 + mi * 32 + r32) * LDA_S + ks * 16 + h * 8;
      a[mi] = *(const bf16x8*)&As[off];
      if (SPLIT) al[mi] = *(const bf16x8*)&Asl[off];
    }
#pragma unroll
    for (int ni = 0; ni < 2; ++ni) {
      const int nrow = (NMAP == 0) ? (wn * 64 + ni * 32) : (ni == 0 ? wn * 32 : 64 + wn * 32);
      const int off = (nrow + r32) * LDA_S + ks * 16 + h * 8;
      const bf16x8 b = *(const bf16x8*)&Bs[off];
      bf16x8 bl;
      if (SPLIT) bl = *(const bf16x8*)&Bsl[off];
#pragma unroll
      for (int mi = 0; mi < 2; ++mi) {
        acc[mi][ni] = MFMA(a[mi], b, acc[mi][ni]);
        if (SPLIT) {
          acc[mi][ni] = MFMA(al[mi], b, acc[mi][ni]);
          acc[mi][ni] = MFMA(a[mi], bl, acc[mi][ni]);
        }
      }
    }
  }
}

template <bool SPLIT, int NMAP, class AF, class BP, bool PF2 = false>
DI void gemm_core(unsigned char* smem, int K, const AF& af, const BP& bp, f32x16 (&acc)[2][2]) {
  const int tid = threadIdx.x, lane = tid & 63, wave = __builtin_amdgcn_readfirstlane(tid >> 6), wm = wave >> 1, wn = wave & 1, r32 = lane & 31, h = lane >> 5;
  const int arow0 = tid >> 2, akc = (tid & 3) * 8;
  typename AF::Raw ra0, ra1;
  typename BP::Raw rb;
#pragma unroll
  for (int mi = 0; mi < 2; ++mi)
#pragma unroll
    for (int ni = 0; ni < 2; ++ni)
#pragma unroll
      for (int i = 0; i < 16; ++i) acc[mi][ni][i] = 0.f;

  af.load(arow0, akc, ra0);
  af.load(arow0 + 64, akc, ra1);
  bp.template load<SPLIT>(0, tid, rb);
  if (!SPLIT && PF2) {
    typename AF::Raw rc0, rc1;
    typename BP::Raw rd;
    gemm_stage_store<SPLIT>(smem, 0, 0, af, bp, ra0, ra1, rb, tid);
    if (32 < K) { af.load(arow0, 32 + akc, ra0); af.load(arow0 + 64, 32 + akc, ra1); bp.template load<SPLIT>(32, tid, rb); }
    if (64 < K) { af.load(arow0, 64 + akc, rc0); af.load(arow0 + 64, 64 + akc, rc1); bp.template load<SPLIT>(64, tid, rd); }
    __syncthreads();
    for (int k0 = 0; k0 < K; k0 += 64) {
      gemm_compute<SPLIT, NMAP>(smem, 0, acc, wm, wn, r32, h);
      if (k0 + 32 < K) gemm_stage_store<SPLIT>(smem, 1, k0 + 32, af, bp, ra0, ra1, rb, tid);
      if (k0 + 96 < K) { af.load(arow0, k0 + 96 + akc, ra0); af.load(arow0 + 64, k0 + 96 + akc, ra1); bp.template load<SPLIT>(k0 + 96, tid, rb); }
      __syncthreads();
      if (k0 + 32 >= K) break;
      gemm_compute<SPLIT, NMAP>(smem, 1, acc, wm, wn, r32, h);
      if (k0 + 64 < K) gemm_stage_store<SPLIT>(smem, 0, k0 + 64, af, bp, rc0, rc1, rd, tid);
      if (k0 + 128 < K) { af.load(arow0, k0 + 128 + akc, rc0); af.load(arow0 + 64, k0 + 128 + akc, rc1); bp.template load<SPLIT>(k0 + 128, tid, rd); }
      __syncthreads();
    }
  } else if (!SPLIT) {
    gemm_stage_store<SPLIT>(smem, 0, 0, af, bp, ra0, ra1, rb, tid);
    __syncthreads();
    int cur = 0;
    for (int k0 = 0; k0 < K; k0 += 32) {
      const bool more = k0 + 32 < K;
      if (more) {
        af.load(arow0, k0 + 32 + akc, ra0);
        af.load(arow0 + 64, k0 + 32 + akc, ra1);
        bp.template load<SPLIT>(k0 + 32, tid, rb);
      }
      gemm_compute<SPLIT, NMAP>(smem, cur, acc, wm, wn, r32, h);
      if (more) gemm_stage_store<SPLIT>(smem, cur ^ 1, k0 + 32, af, bp, ra0, ra1, rb, tid);
      __syncthreads();
      cur ^= 1;
    }
  } else {
    for (int k0 = 0; k0 < K; k0 += 32) {
      __syncthreads();
      gemm_stage_store<SPLIT>(smem, 0, k0, af, bp, ra0, ra1, rb, tid);
      __syncthreads();
      if (k0 + 32 < K) {
        af.load(arow0, k0 + 32 + akc, ra0);
        af.load(arow0 + 64, k0 + 32 + akc, ra1);
        bp.template load<SPLIT>(k0 + 32, tid, rb);
      }
      gemm_compute<SPLIT, NMAP>(smem, 0, acc, wm, wn, r32, h);
    }
    __syncthreads();
  }
}


#if !ORACLE
constexpr int G_STAGE = 16384;
DI int swz_off(int row, int chunk) { return row * 64 + ((chunk ^ ((row >> 2) & 3)) << 4); }
DI void glds16(const bf16_t* gsrc, unsigned char* lds_dst) {
  __builtin_amdgcn_global_load_lds((const unsigned*)gsrc, (__attribute__((address_space(3))) unsigned*)lds_dst, 16, 0, 0);
}
struct AP_rows { const bf16_t* src; int ld; DI const bf16_t* rowptr(int row) const { return src + (size_t)row * ld; } };
struct AP_gather { const bf16_t* h2; const int* rowtok; DI const bf16_t* rowptr(int row) const { return h2 + (size_t)max(rowtok[row], 0) * DM; } };

template <int NMAP>
DI void gemm_compute_g(const unsigned char* st, f32x16 (&acc)[2][2], int wm, int wn, int r32, int h) {
  const unsigned char* As = st;
  const unsigned char* Bs = st + 8192;
  const int sw = (r32 >> 2) & 3;
  bf16x8 a[2][2], b[2][2];
#pragma unroll
  for (int ks = 0; ks < 2; ++ks) {
    const int pc = ((ks * 2 + h) ^ sw) << 4;
#pragma unroll
    for (int mi = 0; mi < 2; ++mi) a[ks][mi] = *(const bf16x8*)(As + (wm * 64 + mi * 32 + r32) * 64 + pc);
#pragma unroll
    for (int ni = 0; ni < 2; ++ni) {
      const int nrow = (NMAP == 0) ? (wn * 64 + ni * 32) : (ni == 0 ? wn * 32 : 64 + wn * 32);
      b[ks][ni] = *(const bf16x8*)(Bs + (nrow + r32) * 64 + pc);
    }
  }
#pragma unroll
  for (int ks = 0; ks < 2; ++ks)
#pragma unroll
    for (int ni = 0; ni < 2; ++ni)
#pragma unroll
      for (int mi = 0; mi < 2; ++mi) acc[mi][ni] = MFMA(a[ks][mi], b[ks][ni], acc[mi][ni]);
}

DI unsigned lds_off(const unsigned char* p) { return (unsigned)(size_t)(__attribute__((address_space(3))) const unsigned char*)p; }
DI void glds16_asm(const bf16_t* gsrc, unsigned lds_dst_uniform) {
  asm volatile("s_mov_b32 m0, %1\n\ts_nop 0\n\tglobal_load_lds_dwordx4 %0, off" :: "v"(gsrc), "s"(lds_dst_uniform) : "memory", "m0");
}
template <int NMAP, class AP>
DI void gemm_core_gg(unsigned char* smem, int K, const AP& ap, const bf16_t* wT, int ldk, int n0, f32x16 (&acc)[2][2]) {
  int tid_ = threadIdx.x;
  asm volatile("" : "+v"(tid_));
  const int tid = tid_, lane = tid & 63, wave = __builtin_amdgcn_readfirstlane(tid >> 6), wm = wave >> 1, wn = wave & 1, r32 = lane & 31, h = lane >> 5;
#pragma unroll
  for (int mi = 0; mi < 2; ++mi)
#pragma unroll
    for (int ni = 0; ni < 2; ++ni)
#pragma unroll
      for (int i = 0; i < 16; ++i) acc[mi][ni][i] = 0.f;
  const int grow = tid >> 2, gc = ((tid & 3) ^ ((tid >> 4) & 3)) * 8;
  const bf16_t* a0 = ap.rowptr(grow) + gc;
  const bf16_t* a1 = ap.rowptr(grow + 64) + gc;
  const bf16_t* b0 = wT + (size_t)(n0 + grow) * ldk + gc;
  const bf16_t* b1 = b0 + (size_t)64 * ldk;
  const unsigned wbase = __builtin_amdgcn_readfirstlane(lds_off(smem) + wave * 1024);
  glds16_asm(a0, wbase); glds16_asm(a1, wbase + 4096); glds16_asm(b0, wbase + 8192); glds16_asm(b1, wbase + 12288);
  glds16_asm(a0 + 32, wbase + G_STAGE); glds16_asm(a1 + 32, wbase + G_STAGE + 4096); glds16_asm(b0 + 32, wbase + G_STAGE + 8192); glds16_asm(b1 + 32, wbase + G_STAGE + 12288);
  int cur = 0;
  for (int k0 = 0; k0 < K; k0 += 32) {
    if (k0 + 32 < K) asm volatile("s_waitcnt vmcnt(4)" ::: "memory");
    else asm volatile("s_waitcnt vmcnt(0)" ::: "memory");
    __builtin_amdgcn_s_barrier();
    asm volatile("" ::: "memory");
    if (k0 + 64 < K) {
      int nx = cur + 2; if (nx >= 3) nx -= 3;
      const unsigned d2 = wbase + nx * G_STAGE;
      glds16_asm(a0 + k0 + 64, d2); glds16_asm(a1 + k0 + 64, d2 + 4096); glds16_asm(b0 + k0 + 64, d2 + 8192); glds16_asm(b1 + k0 + 64, d2 + 12288);
    }
    gemm_compute_g<NMAP>(smem + cur * G_STAGE, acc, wm, wn, r32, h);
    cur = (cur == 2) ? 0 : cur + 1;
  }
  __syncthreads();
}

template <int NMAP, class AP>
DI void gemm_core_gf(unsigned char* smem, int K, const AP& ap, const float* wa, const float* wb, int ldb, int ca, int cb, f32x16 (&acc)[2][2]) {
  const int tid = threadIdx.x, lane = tid & 63, wave = __builtin_amdgcn_readfirstlane(tid >> 6), wm = wave >> 1, wn = wave & 1, r32 = lane & 31, h = lane >> 5;
#pragma unroll
  for (int mi = 0; mi < 2; ++mi)
#pragma unroll
    for (int ni = 0; ni < 2; ++ni)
#pragma unroll
      for (int i = 0; i < 16; ++i) acc[mi][ni][i] = 0.f;
  const int grow = tid >> 2, gc = ((tid & 3) ^ ((tid >> 4) & 3)) * 8;
  const bf16_t* a0 = ap.rowptr(grow) + gc;
  const bf16_t* a1 = ap.rowptr(grow + 64) + gc;
  const int np = tid & 63, kk = tid >> 6;
  const float* bbase = ((np < 32) ? (wa + ca + 2 * np) : (wb + cb + 2 * (np - 32))) + (size_t)(8 * kk) * ldb;
  const int bo0 = swz_off(2 * np, kk), bo1 = swz_off(2 * np + 1, kk);
  unsigned char* dst = smem + tid * 16;
  float2 rb[8];
  auto bload = [&](int k0) {
#pragma unroll
    for (int j = 0; j < 8; ++j) rb[j] = *(const float2*)(bbase + (size_t)(k0 + j) * ldb);
  };
  auto bstore = [&](unsigned char* Bs) {
    float v0[8], v1[8];
#pragma unroll
    for (int j = 0; j < 8; ++j) { v0[j] = rb[j].x; v1[j] = rb[j].y; }
    bf16x8 hi, lo;
    cvt8<false>(v0, hi, lo); *(bf16x8*)(Bs + bo0) = hi;
    cvt8<false>(v1, hi, lo); *(bf16x8*)(Bs + bo1) = hi;
  };
  glds16(a0, dst); glds16(a1, dst + 4096);
  bload(0);
  bstore(smem + 8192);
  __syncthreads();
  int cur = 0;
  for (int k0 = 0; k0 < K; k0 += 32) {
    const bool more = k0 + 32 < K;
    if (more) {
      unsigned char* d2 = dst + (cur ^ 1) * G_STAGE;
      glds16(a0 + k0 + 32, d2); glds16(a1 + k0 + 32, d2 + 4096);
      bload(k0 + 32);
    }
    gemm_compute_g<NMAP>(smem + cur * G_STAGE, acc, wm, wn, r32, h);
    if (more) bstore(smem + (cur ^ 1) * G_STAGE + 8192);
    __syncthreads();
    cur ^= 1;
  }
}
#endif

struct AF_hl {
  struct Raw { u32x4 hv, lv; };
  const bf16_t* hi; const bf16_t* lo; int ld;
  DI void load(int row, int k, Raw& r) const { r.hv = *(const u32x4*)(hi + (size_t)row * ld + k); r.lv = *(const u32x4*)(lo + (size_t)row * ld + k); }
  DI void cvt(const Raw& r, int, int, bf16x8& h, bf16x8& l) const { h = __builtin_bit_cast(bf16x8, r.hv); l = __builtin_bit_cast(bf16x8, r.lv); }
};


#if !ORACLE
template <int CPR, class RowPtr, bool NT = false>
DI void epi_flush_bf16(const bf16_t* T, int ld, int rows, RowPtr rp) {
  const int total = rows * CPR;
  for (int c = threadIdx.x; c < total; c += NTHREADS) {
    const int row = c / CPR, cc = (c % CPR) * 8;
    bf16_t* d = rp(row);
    if (d) {
      const u32x4 v = *(const u32x4*)&T[row * ld + cc];
      if (NT) __builtin_nontemporal_store(v, (u32x4*)(d + cc));
      else *(u32x4*)(d + cc) = v;
    }
  }
}
#endif

DI void prep_tile(unsigned char* smem, const float* src, int ld_src, bf16_t* dhi, bf16_t* dlo, int K, int kt, int nt, int mode, int nsrc) {
  if (mode == 1) K = LDH;
  float* T = (float*)smem;
  const int tid = threadIdx.x;
  __syncthreads();
  {
    const int kk = tid >> 4, n4 = (tid & 15) * 4;
#pragma unroll
    for (int i = 0; i < 4; ++i) {
      const int k = kt * 64 + kk + 16 * i;
      float v[4];
#pragma unroll
      for (int e = 0; e < 4; ++e) {
        const int nd = nt * 64 + n4 + e;
        int ns = nd;
        if (mode == 1) ns = (nd >= 920 && nd < 960) ? -1 : (nd < 920 ? nd : nd - 40);
        v[e] = (ns >= 0 && ns < nsrc) ? src[(size_t)k * ld_src + ns] : 0.f;
      }
#pragma unroll
      for (int e = 0; e < 4; ++e) T[(n4 + e) * 65 + kk + 16 * i] = v[e];
    }
  }
  __syncthreads();
  {
    const int n = tid >> 2, kc = (tid & 3) * 16;
    float v[8];
    bf16x8 hi, lo;
#pragma unroll
    for (int half = 0; half < 2; ++half) {
#pragma unroll
      for (int j = 0; j < 8; ++j) v[j] = T[n * 65 + kc + half * 8 + j];
      cvt8<true>(v, hi, lo);
      const size_t o = (size_t)(nt * 64 + n) * K + kt * 64 + kc + half * 8;
      *(bf16x8*)(dhi + o) = hi;
      *(bf16x8*)(dlo + o) = lo;
    }
  }
}

template <int PART>
DI void phase0(const Params& p, unsigned char* smem) {
  const int tid = threadIdx.x;
  if (PART == 0 && blockIdx.x == 0) {
    for (int i = tid; i < NEXP + 1; i += NTHREADS) p.cnt[i * CNT_STRIDE] = 0;
    if (tid < 8) p.ctr[tid] = 0;
  }
  constexpr int T_MOD = 192, T_ROPE = 512;
  constexpr int T_WIN = 16 * 40, T_WOUT = 16 * 16, T_WR = 16 * 4, T_W1 = 32 * 4, T_W2 = 4;
  constexpr int E0 = T_MOD + T_ROPE, E1 = E0 + T_WIN, E2 = E1 + T_WOUT, E3 = E2 + T_WR, E4 = E3 + T_W1, E5 = E4 + T_W1, E6 = E5 + T_W2, E7 = E6 + T_W2;
  for (int tile = (PART == 0 ? 0 : E0) + blockIdx.x; tile < (PART == 0 ? E0 : E7); tile += gridDim.x) {
    if (tile < T_MOD) {
      float* cond = (float*)smem;
      float* red = cond + 8 * 1024;
      __syncthreads();
      {
        float4 cv[8];
#pragma unroll
        for (int q = 0; q < 8; ++q) cv[q] = *(const float4*)(p.c + (q * NTHREADS + tid) * 4);
#pragma unroll
        for (int q = 0; q < 8; ++q) {
          const int i = (q * NTHREADS + tid) * 4;
          cond[i] = siluf_(cv[q].x); cond[i + 1] = siluf_(cv[q].y); cond[i + 2] = siluf_(cv[q].z); cond[i + 3] = siluf_(cv[q].w);
        }
      }
      __syncthreads();
      const int col = tid & 31, kp = tid >> 5, j0 = tile * 32;
      float a[8];
#pragma unroll
      for (int b = 0; b < 8; ++b) a[b] = 0.f;
      for (int k0 = kp * 128; k0 < kp * 128 + 128; k0 += 16) {
        float w[16];
#pragma unroll
        for (int u = 0; u < 16; ++u) w[u] = p.w_ada[(size_t)(k0 + u) * 6144 + j0 + col];
#pragma unroll
        for (int u = 0; u < 16; ++u)
#pragma unroll
          for (int b = 0; b < 8; ++b) a[b] += cond[b * 1024 + k0 + u] * w[u];
      }
#pragma unroll
      for (int b = 0; b < 8; ++b) red[(kp * 8 + b) * 32 + col] = a[b];
      __syncthreads();
      {
        const int b = tid >> 5;
        float sacc = 0.f;
#pragma unroll
        for (int q = 0; q < 8; ++q) sacc += red[(q * 8 + b) * 32 + col];
        p.mod[b * 6144 + j0 + col] = sacc + p.b_ada[j0 + col];
      }
    } else if (tile < E0) {
      const int idx = (tile - T_MOD) * 256 + tid;
      const int pos = idx >> 5, i = idx & 31;
      const float inv = (float)pow(10000.0, -(double)(2 * i) / 64.0);
      const float ang = (float)pos * inv;
      *(float2*)(p.ropec + 2 * idx) = make_float2((float)cos((double)ang), (float)sin((double)ang));
    } else if (tile < E1) { const int t = tile - E0; prep_tile(smem, p.w_in, INC, p.winT, p.winTl, 1024, t / 40, t % 40, 1, INC); }
    else if (tile < E2) { const int t = tile - E1; prep_tile(smem, p.w_out, 1024, p.woutT, p.woutTl, 1024, t >> 4, t & 15, 0, 1024); }
    else if (tile < E3) { const int t = tile - E2; prep_tile(smem, p.w_router, 256, p.wrT, p.wrTl, 1024, t >> 2, t & 3, 0, 256); }
    else if (tile < E4) { const int t = tile - E3; prep_tile(smem, p.w1_k, 256, p.w1kT, p.w1kTl, 2048, t >> 2, t & 3, 0, 256); }
    else if (tile < E5) { const int t = tile - E4; prep_tile(smem, p.w1_v, 256, p.w1vT, p.w1vTl, 2048, t >> 2, t & 3, 0, 256); }
    else if (tile < E6) { const int t = tile - E5; prep_tile(smem, p.w2_k, 64, p.w2kT, p.w2kTl, 256, t, 0, 0, 64); }
    else { const int t = tile - E6; prep_tile(smem, p.w2_v, 64, p.w2vT, p.w2vTl, 256, t, 0, 0, 64); }
  }
}

#if ORACLE
DI void phase0b(const Params& p) {
  const int tid = otid(), lane = tid & 63, wave = __builtin_amdgcn_readfirstlane(tid >> 6);
  const int gw = blockIdx.x * 4 + wave, nw = gridDim.x * 4;
  for (int tok = gw; tok < NT; tok += nw) {
    const int b = tok >> 12;
    const float* xr = p.x + (size_t)tok * DM;
    float4 xv[4];
    float ss = 0.f;
#pragma unroll
    for (int j = 0; j < 4; ++j) {
      xv[j] = *(const float4*)(xr + lane * 4 + 256 * j);
      ss += xv[j].x * xv[j].x + xv[j].y * xv[j].y + xv[j].z * xv[j].z + xv[j].w * xv[j].w;
    }
    ss = wave_sum(ss);
    const float rsv = 1.0f / sqrtf(ss * (1.0f / DM) + 1e-6f);
    act_t* hr = p.h1 + (size_t)tok * LDH;
#pragma unroll
    for (int j = 0; j < 4; ++j) {
      const int c = lane * 4 + 256 * j;
      const float4 g = *(const float4*)(p.g_attn + c);
      const float4 sc = *(const float4*)(p.mod + b * 6144 + 1024 + c);
      const float4 sh = *(const float4*)(p.mod + b * 6144 + c);
      st4(hr + c, xv[j].x * rsv * (g.x * (1.0f + sc.x)) + sh.x, xv[j].y * rsv * (g.y * (1.0f + sc.y)) + sh.y,
          xv[j].z * rsv * (g.z * (1.0f + sc.z)) + sh.z, xv[j].w * rsv * (g.w * (1.0f + sc.w)) + sh.w);
    }
  }
}
#else
DI void phase0b(const Params& p) {
  const int tid = otid(), lane = tid & 63, wave = __builtin_amdgcn_readfirstlane(tid >> 6);
  const int gw = blockIdx.x * 4 + wave, nw = gridDim.x * 4;
  for (int tok = gw; tok < NT; tok += nw) {
    const int b = tok >> 12;
    const float* xr = p.x + (size_t)tok * DM;
    float xv[16];
    float ss = 0.f;
#pragma unroll
    for (int j = 0; j < 2; ++j) {
      const float4 a0 = *(const float4*)(xr + lane * 8 + 512 * j), a1 = *(const float4*)(xr + lane * 8 + 512 * j + 4);
      float* xx = xv + 8 * j;
      xx[0] = a0.x; xx[1] = a0.y; xx[2] = a0.z; xx[3] = a0.w; xx[4] = a1.x; xx[5] = a1.y; xx[6] = a1.z; xx[7] = a1.w;
#pragma unroll
      for (int q = 0; q < 8; ++q) ss += xx[q] * xx[q];
    }
    ss = wave_sum(ss);
    const float rsv = 1.0f / sqrtf(ss * (1.0f / DM) + 1e-6f);
    act_t* hr = p.h1 + (size_t)tok * LDH;
#pragma unroll
    for (int j = 0; j < 2; ++j) {
      const int c = lane * 8 + 512 * j;
      float o[8];
#pragma unroll
      for (int hh = 0; hh < 2; ++hh) {
        const float4 g = *(const float4*)(p.g_attn + c + 4 * hh);
        const float4 sc = *(const float4*)(p.mod + b * 6144 + 1024 + c + 4 * hh);
        const float4 sh = *(const float4*)(p.mod + b * 6144 + c + 4 * hh);
        const float* xx = xv + 8 * j + 4 * hh;
        o[4 * hh] = xx[0] * rsv * (g.x * (1.0f + sc.x)) + sh.x; o[4 * hh + 1] = xx[1] * rsv * (g.y * (1.0f + sc.y)) + sh.y;
        o[4 * hh + 2] = xx[2] * rsv * (g.z * (1.0f + sc.z)) + sh.z; o[4 * hh + 3] = xx[3] * rsv * (g.w * (1.0f + sc.w)) + sh.w;
      }
      st8bf(hr + c, o);
    }
  }
}
#endif

template <class T> struct AF_rows {
  typedef typename RawOf<T>::type Raw;
  const T* src; int ld;
  DI void load(int row, int k, Raw& r) const { raw_load(src + (size_t)row * ld + k, r); }
  DI void cvt(const Raw& r, int row, int k, bf16x8& hi, bf16x8& lo) const { raw_frag<kSplit>(r, hi, lo); }
};

DI void phase1(const Params& p, unsigned char* smem) {
  const int tid = threadIdx.x, lane = tid & 63, wave = __builtin_amdgcn_readfirstlane(tid >> 6), wm = wave >> 1, wn = wave & 1, r32 = lane & 31, h = lane >> 5;
  const int vbid = (blockIdx.x & 7) * (gridDim.x >> 3) + (blockIdx.x >> 3);
  for (int tile = vbid; tile < 256 * 20; tile += gridDim.x) {
    const int grp = tile / 1280, tg = tile % 1280;
    const int mt = tg / 5, nt = grp * 5 + tg % 5;
    const int b = mt >> 5, t0 = mt * 128;
    AF_rows<act_t> af; af.src = p.h1 + (size_t)t0 * LDH; af.ld = LDH;
    BT16 bp; bp.w = p.winT; bp.wlo = p.winTl; bp.ldk = LDH; bp.n0 = nt * 128;
    f32x16 acc[2][2];
#if ORACLE
    gemm_core<kSplit, 0, AF_rows<act_t>, BT16, false>(smem, DM, af, bp, acc);
#else
    { AP_rows ap; ap.src = af.src; ap.ld = LDH; gemm_core_gg<0>(smem, DM, ap, p.winT, LDH, nt * 128, acc); }
#endif
    const int eslot = nt * 2 + wn;
#if ORACLE
    if (eslot >= 39) continue;
    const bool is_q = (eslot < 8) || (eslot >= SLOT_MQ && eslot < SLOT_MQ + 8);
    const bool is_rope = is_q || eslot == SLOT_KCMP || eslot == SLOT_KSLC || eslot == SLOT_KWIN || (eslot >= SLOT_MK && eslot < SLOT_MK + 8);
    const bool is_vt = eslot == SLOT_VSLC || eslot == SLOT_VWIN || eslot >= SLOT_MV;
    const int posb = (mt & 31) * 128;
    if (is_vt) {
      const int vidx = (eslot == SLOT_VSLC) ? b : ((eslot == SLOT_VWIN) ? 8 + b : 16 + b * 8 + (eslot - SLOT_MV));
      act_t* vb = p.vT_slc + (size_t)vidx * 64 * SEQ;
#pragma unroll
      for (int mi = 0; mi < 2; ++mi)
#pragma unroll
        for (int ni = 0; ni < 2; ++ni)
#pragma unroll
          for (int g = 0; g < 4; ++g) {
            const int pos = posb + wm * 64 + mi * 32 + 8 * g + 4 * h;
            const int d = ni * 32 + r32;
            st4(vb + (size_t)d * SEQ + pos, acc[mi][ni][4 * g], acc[mi][ni][4 * g + 1], acc[mi][ni][4 * g + 2], acc[mi][ni][4 * g + 3]);
          }
    } else {
#pragma unroll
      for (int mi = 0; mi < 2; ++mi)
#pragma unroll
        for (int i = 0; i < 16; ++i) {
          const int tl = wm * 64 + mi * 32 + crow(i, h);
          const int pos = posb + tl;
          float t1 = acc[mi][0][i], t2 = acc[mi][1][i];
          act_t* dst = p.proj + (size_t)(t0 + tl) * NP + eslot * 64 + r32;
          if (is_rope) {
            const float2 csn = *(const float2*)(p.ropec + 2 * (pos * 32 + r32));
            const float cs = csn.x, sn = csn.y;
            float o1 = t1 * cs - t2 * sn, o2 = t2 * cs + t1 * sn;
            if (is_q) { o1 *= QSCALE; o2 *= QSCALE; }
            st1(dst, o1); st1(dst + 32, o2);
          } else if (eslot == SLOT_GATE) {
            if (r32 < 24) st1(dst, sigmoidf_(t1));
          } else {
            st1(dst, t1); st1(dst + 32, t2);
          }
        }
    }
#else
    {
      const bool is_q = (eslot < 8) || (eslot >= SLOT_MQ && eslot < SLOT_MQ + 8);
      const bool is_rope = is_q || eslot == SLOT_KCMP || eslot == SLOT_KSLC || eslot == SLOT_KWIN || (eslot >= SLOT_MK && eslot < SLOT_MK + 8);
      const bool is_vt = eslot == SLOT_VSLC || eslot == SLOT_VWIN || (eslot >= SLOT_MV && eslot < 39);
      const int posb = (mt & 31) * 128;
      bf16_t* T = (bf16_t*)smem + wn * (128 * 72);
      if (eslot < 39) {
        if (is_vt) {
#pragma unroll
          for (int mi = 0; mi < 2; ++mi)
#pragma unroll
            for (int ni = 0; ni < 2; ++ni)
#pragma unroll
              for (int g = 0; g < 4; ++g) {
                uint2 u;
                u.x = pack2bf(acc[mi][ni][4 * g], acc[mi][ni][4 * g + 1]);
                u.y = pack2bf(acc[mi][ni][4 * g + 2], acc[mi][ni][4 * g + 3]);
                *(uint2*)&T[(ni * 32 + r32) * 136 + wm * 64 + mi * 32 + 8 * g + 4 * h] = u;
              }
        } else {
          if (is_rope) {
            const float qs = is_q ? QSCALE : 1.0f;
#pragma unroll
            for (int mi = 0; mi < 2; ++mi) {
              float2 csn[16];
#pragma unroll
              for (int i = 0; i < 16; ++i) csn[i] = *(const float2*)(p.ropec + 2 * ((posb + wm * 64 + mi * 32 + crow(i, h)) * 32 + r32));
#pragma unroll
              for (int i = 0; i < 16; ++i) {
                const int tl = wm * 64 + mi * 32 + crow(i, h);
                const float t1 = acc[mi][0][i], t2 = acc[mi][1][i];
                float o1 = t1 * csn[i].x - t2 * csn[i].y, o2 = t2 * csn[i].x + t1 * csn[i].y;
                if (is_q) { o1 *= QSCALE; o2 *= QSCALE; }
                T[tl * 72 + r32] = f2bf(o1);
                T[tl * 72 + 32 + r32] = f2bf(o2);
              }
            }
            (void)qs;
          } else if (eslot == SLOT_GATE) {
#pragma unroll
            for (int mi = 0; mi < 2; ++mi)
#pragma unroll
              for (int i = 0; i < 16; ++i) {
                const int tl = wm * 64 + mi * 32 + crow(i, h);
                T[tl * 72 + r32] = f2bf(sigmoidf_fast(acc[mi][0][i]));
                T[tl * 72 + 32 + r32] = f2bf(acc[mi][1][i]);
              }
          } else {
#pragma unroll
            for (int mi = 0; mi < 2; ++mi)
#pragma unroll
              for (int i = 0; i < 16; ++i) {
                const int tl = wm * 64 + mi * 32 + crow(i, h);
                T[tl * 72 + r32] = f2bf(acc[mi][0][i]);
                T[tl * 72 + 32 + r32] = f2bf(acc[mi][1][i]);
              }
          }
        }
      }
      __syncthreads();
#pragma unroll 1
      for (int half = 0; half < 2; ++half) {
        const int sl = nt * 2 + half;
        if (sl >= 39) break;
        const bf16_t* Th = (const bf16_t*)smem + half * (128 * 72);
        const bool vt = sl == SLOT_VSLC || sl == SLOT_VWIN || sl >= SLOT_MV;
        if (vt) {
          const int vidx = (sl == SLOT_VSLC) ? b : ((sl == SLOT_VWIN) ? 8 + b : 16 + b * 8 + (sl - SLOT_MV));
          bf16_t* vb = p.vT_slc + (size_t)vidx * 64 * SEQ + posb;
          { auto rp = [&](int d) { return vb + (size_t)d * SEQ; }; epi_flush_bf16<16, decltype(rp), true>(Th, 136, 64, rp); }
        } else {
          bf16_t* pb = p.proj + (size_t)t0 * NP + sl * 64;
          { auto rp = [&](int r) { return pb + (size_t)r * NP; }; epi_flush_bf16<8, decltype(rp), true>(Th, 72, 128, rp); }
        }
      }
      __syncthreads();
    }
#endif
  }
}

struct AF_cmp {
  typedef typename RawOf<act_t>::type Raw;
  const act_t* proj; const float* pos; int r0; int col; int l0;
  DI void load(int row, int k, Raw& r) const {
    const int rr = r0 + row, b = rr >> 8, n = rr & 255, l = l0 + (k >> 6), d = k & 63;
    raw_load(proj + (size_t)(b * SEQ + 16 * n + l) * NP + col + d, r);
  }
  DI void cvt(const Raw& r, int row, int k, bf16x8& hi, bf16x8& lo) const {
    float v[8];
    raw_floats(r, v);
#pragma unroll
    for (int j = 0; j < 8; ++j) v[j] += pos[k + j];
    cvt8<kSplit>(v, hi, lo);
  }
};

DI void phase2a(const Params& p, unsigned char* smem) {
  const int tid = threadIdx.x, lane = tid & 63, wave = __builtin_amdgcn_readfirstlane(tid >> 6), wm = wave >> 1, wn = wave & 1, r32 = lane & 31, h = lane >> 5;
  for (int tile = blockIdx.x; tile < 256 + 128; tile += gridDim.x) {
    if (tile < 256) {
      const int ks = tile >> 6, which = (tile >> 5) & 1, mt = (tile >> 1) & 15, nt = tile & 1;
      AF_cmp af; af.proj = p.proj; af.pos = (which ? p.pos_v : p.pos_k) + ks * 512; af.r0 = mt * 128; af.col = (which ? SLOT_VCMP : SLOT_KCMP) * 64; af.l0 = ks * 8;
      BT16 bp; bp.w = (which ? p.w1vT : p.w1kT) + ks * 512; bp.wlo = (which ? p.w1vTl : p.w1kTl) + ks * 512; bp.ldk = 2048; bp.n0 = nt * 128;
      f32x16 acc[2][2];
      gemm_core<kSplit, 0>(smem, 512, af, bp, acc);
      float* hb = p.hidp + (size_t)(ks * 2 + which) * 2048 * 256;
#pragma unroll
      for (int mi = 0; mi < 2; ++mi)
#pragma unroll
        for (int ni = 0; ni < 2; ++ni)
#pragma unroll
          for (int i = 0; i < 16; ++i) {
            const int r = mt * 128 + wm * 64 + mi * 32 + crow(i, h);
            const int cc = nt * 128 + wn * 64 + ni * 32 + r32;
            hb[(size_t)r * 256 + cc] = acc[mi][ni][i];
          }
    } else {
      const int it = tile - 256, b = it >> 4, blk = it & 15;
      const int cg = tid & 63, tq = tid >> 6;
      const act_t* src = p.proj + (size_t)(b * SEQ + blk * 256 + tq * 64) * NP + SLOT_MK * 64 + 8 * cg;
      float sum[8];
#pragma unroll
      for (int j = 0; j < 8; ++j) sum[j] = 0.f;
#pragma unroll 8
      for (int t = 0; t < 64; ++t) {
        typename RawOf<act_t>::type r;
        raw_load(src + (size_t)t * NP, r);
        float v[8];
        raw_floats(r, v);
#pragma unroll
        for (int j = 0; j < 8; ++j) sum[j] += v[j];
      }
      float* red = (float*)smem;
      __syncthreads();
#pragma unroll
      for (int j = 0; j < 8; ++j) red[tq * 512 + 8 * cg + j] = sum[j];
      __syncthreads();
      {
        const int c0 = 2 * tid, hd = c0 >> 6, d = c0 & 63;
        float* dst = p.kmean + (size_t)((b * 8 + hd) * 16 + blk) * 64 + d;
        dst[0] = (red[c0] + red[512 + c0] + red[1024 + c0] + red[1536 + c0]) * (1.0f / 256.0f);
        dst[1] = (red[c0 + 1] + red[512 + c0 + 1] + red[1024 + c0 + 1] + red[1536 + c0 + 1]) * (1.0f / 256.0f);
      }
    }
  }
}

struct AF_hidsum {
  struct Raw { float4 v[8]; };
  const float* src;
  DI void load(int row, int k, Raw& r) const {
#pragma unroll
    for (int ks = 0; ks < 4; ++ks) {
      const float* q = src + (size_t)ks * 2 * 2048 * 256 + (size_t)row * 256 + k;
      r.v[2 * ks] = *(const float4*)q; r.v[2 * ks + 1] = *(const float4*)(q + 4);
    }
  }
  DI void cvt(const Raw& r, int, int, bf16x8& hi, bf16x8& lo) const {
    float v[8];
    v[0] = r.v[0].x + r.v[2].x + r.v[4].x + r.v[6].x; v[1] = r.v[0].y + r.v[2].y + r.v[4].y + r.v[6].y;
    v[2] = r.v[0].z + r.v[2].z + r.v[4].z + r.v[6].z; v[3] = r.v[0].w + r.v[2].w + r.v[4].w + r.v[6].w;
    v[4] = r.v[1].x + r.v[3].x + r.v[5].x + r.v[7].x; v[5] = r.v[1].y + r.v[3].y + r.v[5].y + r.v[7].y;
    v[6] = r.v[1].z + r.v[3].z + r.v[5].z + r.v[7].z; v[7] = r.v[1].w + r.v[3].w + r.v[5].w + r.v[7].w;
#pragma unroll
    for (int j = 0; j < 8; ++j) v[j] = siluf_(v[j]);
    cvt8<kSplit>(v, hi, lo);
  }
};

DI void phase2b(const Params& p, unsigned char* smem) {
  const int tid = threadIdx.x, lane = tid & 63, wave = __builtin_amdgcn_readfirstlane(tid >> 6), wm = wave >> 1, wn = wave & 1, r32 = lane & 31, h = lane >> 5;
  for (int tile = blockIdx.x; tile < 32; tile += gridDim.x) {
    const int which = tile >> 4, mt = tile & 15;
    AF_hidsum af; af.src = p.hidp + (size_t)which * 2048 * 256 + (size_t)mt * 128 * 256;
    BT16 bp; bp.w = which ? p.w2vT : p.w2kT; bp.wlo = which ? p.w2vTl : p.w2kTl; bp.ldk = 256; bp.n0 = 0;
    f32x16 acc[2][2];
    gemm_core<kSplit, 0>(smem, 256, af, bp, acc);
    if (wn != 0) continue;
    if (which == 0) {
#pragma unroll
      for (int mi = 0; mi < 2; ++mi)
#pragma unroll
        for (int ni = 0; ni < 2; ++ni)
#pragma unroll
          for (int i = 0; i < 16; ++i) {
            const int r = mt * 128 + wm * 64 + mi * 32 + crow(i, h);
            st1(p.kc + (size_t)r * 64 + ni * 32 + r32, acc[mi][ni][i]);
          }
    } else {
#pragma unroll
      for (int mi = 0; mi < 2; ++mi)
#pragma unroll
        for (int ni = 0; ni < 2; ++ni)
#pragma unroll
          for (int g = 0; g < 4; ++g) {
            const int r = mt * 128 + wm * 64 + mi * 32 + 8 * g + 4 * h;
            const int b = r >> 8, n = r & 255, d = ni * 32 + r32;
            st4(p.vcT + (size_t)(b * 64 + d) * 256 + n, acc[mi][ni][4 * g], acc[mi][ni][4 * g + 1], acc[mi][ni][4 * g + 2], acc[mi][ni][4 * g + 3]);
          }
    }
  }
}

constexpr int KS_LD = 72, VS_LD = 68;
constexpr int KS_BYTES = 64 * KS_LD * 2, VS_BYTES = 64 * VS_LD * 2;
struct FlashSt { f32x16 o[2][2]; float m[2]; float l[2]; };
struct AttnLds { bf16_t *Ks, *Vs, *Qs; };
constexpr int QS_BYTES = 4 * 2 * 4 * 64 * 16;

DI void flash_init(FlashSt& st) {
#pragma unroll
  for (int qi = 0; qi < 2; ++qi) {
    st.m[qi] = -1e30f; st.l[qi] = 0.f;
#pragma unroll
    for (int dt = 0; dt < 2; ++dt)
#pragma unroll
      for (int i = 0; i < 16; ++i) st.o[qi][dt][i] = 0.f;
  }
}

DI void qk_tile(const AttnLds& L, f32x16 (&s)[2][2], int lane) {
  const int r32 = lane & 31, h = lane >> 5;
#pragma unroll
  for (int kt = 0; kt < 2; ++kt)
#pragma unroll
    for (int qi = 0; qi < 2; ++qi)
#pragma unroll
      for (int i = 0; i < 16; ++i) s[kt][qi][i] = 0.f;
#pragma unroll
  for (int kt = 0; kt < 2; ++kt)
#pragma unroll
    for (int ks = 0; ks < 4; ++ks) {
      const int off = (kt * 32 + r32) * KS_LD + ks * 16 + h * 8;
      const bf16x8 a = *(const bf16x8*)&L.Ks[off];
#pragma unroll
      for (int qi = 0; qi < 2; ++qi) {
        const bf16x8 qv = *(const bf16x8*)&L.Qs[((qi * 4 + ks) * 64 + lane) * 8];
        s[kt][qi] = MFMA(a, qv, s[kt][qi]);
      }
    }
}

constexpr float LZ_HI = 8.0f, LZ_LO = -64.0f;
template <int QI, class MaskF>
DI void flash_half(const AttnLds& L, FlashSt& st, int mode, const MaskF& mf, int lane) {
  const int r32 = lane & 31, h = lane >> 5;
  const float mref = st.m[QI];
  const bool fresh = mref < -1e29f;
  const float base = fresh ? 0.f : mref;
  float cinit = -base;
  if (mode == 1) cinit = mf.live(QI) ? cinit : -INFINITY;
  f32x16 s[2];
#pragma unroll
  for (int kt = 0; kt < 2; ++kt)
#pragma unroll
    for (int i = 0; i < 16; ++i) s[kt][i] = cinit;
#pragma unroll
  for (int kt = 0; kt < 2; ++kt)
#pragma unroll
    for (int ks = 0; ks < 4; ++ks) {
      const bf16x8 a = *(const bf16x8*)&L.Ks[(kt * 32 + r32) * KS_LD + ks * 16 + h * 8];
      const bf16x8 qv = *(const bf16x8*)&L.Qs[((QI * 4 + ks) * 64 + lane) * 8];
      s[kt] = MFMA(a, qv, s[kt]);
    }
  if (mode == 2) {
    int kofs = 4 * h;
    asm volatile("; per-element mask" : "+v"(kofs) :: "memory");
#pragma unroll
    for (int kt = 0; kt < 2; ++kt)
#pragma unroll
      for (int i = 0; i < 16; ++i)
        if (!mf.vis(QI, kt * 32 + crow(i, 0) + kofs)) s[kt][i] = -INFINITY;
  }
  float mx = -INFINITY;
#pragma unroll
  for (int kt = 0; kt < 2; ++kt)
#pragma unroll
    for (int i = 0; i < 16; ++i) mx = fmaxf(mx, s[kt][i]);
  mx = pair_max32(mx);
  const bool anyvis = mx > -INFINITY;
  const bool need = fresh ? (anyvis && (mx > LZ_HI || mx < LZ_LO)) : (mx > LZ_HI);
  st.m[QI] = need ? base + mx : ((fresh && !anyvis) ? mref : base);
  if (__builtin_amdgcn_ballot_w64(need) != 0ull) {
    asm volatile("; rescale path" ::: "memory");
    const float delta = need ? mx : 0.f;
    const float alpha = __builtin_amdgcn_exp2f(-fmaxf(delta, 0.f));
    st.l[QI] *= alpha;
#pragma unroll
    for (int dt = 0; dt < 2; ++dt)
#pragma unroll
      for (int i = 0; i < 16; ++i) st.o[QI][dt][i] *= alpha;
#pragma unroll
    for (int kt = 0; kt < 2; ++kt)
#pragma unroll
      for (int i = 0; i < 16; ++i) s[kt][i] -= delta;
  }
  float sum = 0.f;
#pragma unroll
  for (int kt = 0; kt < 2; ++kt)
#pragma unroll
    for (int i = 0; i < 16; ++i) {
      const float pv = __builtin_amdgcn_exp2f(s[kt][i]);
      s[kt][i] = pv;
      sum += pv;
    }
  st.l[QI] += sum;
#pragma unroll
  for (int kt = 0; kt < 2; ++kt)
#pragma unroll
    for (int s2 = 0; s2 < 2; ++s2) {
      bf16x8 ph;
#pragma unroll
      for (int j = 0; j < 8; ++j) ph[j] = (short)f2bf(s[kt][8 * s2 + j]);
#pragma unroll
      for (int dt = 0; dt < 2; ++dt) {
        const int off = (dt * 32 + r32) * VS_LD + kt * 32 + s2 * 16 + 4 * h;
        const s16x4 a0 = *(const s16x4*)&L.Vs[off];
        const s16x4 a1 = *(const s16x4*)&L.Vs[off + 8];
        const bf16x8 vh = __builtin_shufflevector(a0, a1, 0, 1, 2, 3, 4, 5, 6, 7);
        st.o[QI][dt] = MFMA(vh, ph, st.o[QI][dt]);
      }
    }
}
template <class MaskF>
DI void flash_tile(const AttnLds& L, FlashSt& st, int mode, const MaskF& mf, int lane) {
  flash_half<0>(L, st, mode, mf, lane);
  flash_half<1>(L, st, mode, mf, lane);
}

typedef typename RawOf<act_t>::type RawA;
DI void stage_k_load(const act_t* kb, size_t kstride, int tid, RawA (&rk)[2]) {
  const int row = tid >> 3, dc = (tid & 7) * 8;
  raw_load(kb + (size_t)row * kstride + dc, rk[0]);
  raw_load(kb + (size_t)(row + 32) * kstride + dc, rk[1]);
}
DI void stage_v_load(const act_t* vb, size_t vstride, int tid, RawA (&rv)[2]) {
  const int row = tid >> 3, kc = (tid & 7) * 8;
  raw_load(vb + (size_t)row * vstride + kc, rv[0]);
  raw_load(vb + (size_t)(row + 32) * vstride + kc, rv[1]);
}
DI void stage_k_store(const AttnLds& L, int tid, const RawA (&rk)[2]) {
  const int row = tid >> 3, dc = (tid & 7) * 8;
#pragma unroll
  for (int i = 0; i < 2; ++i) {
    bf16x8 hi, lo;
    raw_frag<false>(rk[i], hi, lo);
    *(bf16x8*)&L.Ks[(row + 32 * i) * KS_LD + dc] = hi;
  }
}
DI void stage_v_store(const AttnLds& L, int tid, const RawA (&rv)[2]) {
  const int row = tid >> 3, kc = (tid & 7) * 8;
#pragma unroll
  for (int i = 0; i < 2; ++i) {
    bf16x8 hi, lo;
    raw_frag<false>(rv[i], hi, lo);
    const int off = (row + 32 * i) * VS_LD + kc;
    *(s16x4*)&L.Vs[off] = __builtin_shufflevector(hi, hi, 0, 1, 2, 3);
    *(s16x4*)&L.Vs[off + 4] = __builtin_shufflevector(hi, hi, 4, 5, 6, 7);
  }
}

constexpr int KV2_OFF = 60416;
template <class MaskGen>
DI void run_branch(const AttnLds& L, const act_t* kbase, size_t kstride, const act_t* vbase, size_t vstride, int j0, int j1,
                   MaskGen& mg, FlashSt& st, int tid) {
  const int lane = tid & 63;
  if (j0 >= j1) return;
  RawA rk[2], rv[2];
  stage_k_load(kbase + (size_t)j0 * 64 * kstride, kstride, tid, rk);
  stage_v_load(vbase + (size_t)j0 * 64, vstride, tid, rv);
  __syncthreads();
  stage_k_store(L, tid, rk);
  stage_v_store(L, tid, rv);
  if (j0 + 1 < j1) {
    stage_k_load(kbase + (size_t)(j0 + 1) * 64 * kstride, kstride, tid, rk);
    stage_v_load(vbase + (size_t)(j0 + 1) * 64, vstride, tid, rv);
  }
  __syncthreads();
  int cur = 0;
  for (int j = j0; j < j1; ++j) {
    AttnLds Lc = L, Ln = L;
    Lc.Ks = L.Ks + cur * (KV2_OFF / 2); Lc.Vs = L.Vs + cur * (KV2_OFF / 2);
    Ln.Ks = L.Ks + (cur ^ 1) * (KV2_OFF / 2); Ln.Vs = L.Vs + (cur ^ 1) * (KV2_OFF / 2);
    if (!mg.skip(j)) {
      mg.set(j);
      const int md = __builtin_amdgcn_readfirstlane(mg.mode(j));
      flash_tile(Lc, st, md, mg, lane);
    }
    if (j + 1 < j1) {
      stage_k_store(Ln, tid, rk);
      stage_v_store(Ln, tid, rv);
      if (j + 2 < j1) {
        stage_k_load(kbase + (size_t)(j + 2) * 64 * kstride, kstride, tid, rk);
        stage_v_load(vbase + (size_t)(j + 2) * 64, vstride, tid, rv);
      }
    }
    __syncthreads();
    cur ^= 1;
  }
}

struct CmpMask {
  int t; int t0; int jj;
  DI bool skip(int) const { return false; }
  DI void set(int j) { jj = j; }
  DI int mode(int j) const { return (16 * (64 * j + 63) + 31 > t0) ? 2 : 0; }
  DI bool live(int) const { return true; }
  DI bool vis(int, int key) const { return 16 * (64 * jj + key) + 31 <= t; }
};
struct SlcMask {
  unsigned long long msk; int cur; int t; int jj; bool sel;
  DI bool skip(int) const { return false; }
  DI void set(int j) { jj = j; sel = (msk >> j) & 1ull; }
  DI int mode(int j) const { return (j == cur) ? 2 : (__all(sel) ? 0 : 1); }
  DI bool live(int) const { return sel; }
  DI bool vis(int, int key) const { return sel && (64 * jj + key <= t); }
};
struct WinMask {
  int t; int t0; int jj;
  DI bool skip(int) const { return false; }
  DI void set(int j) { jj = j; }
  DI int mode(int j) const { return ((64 * j + 63 > t0) || (64 * j <= t0 + 31 - 512)) ? 2 : 0; }
  DI bool live(int) const { return true; }
  DI bool vis(int, int key) const { const int kp = 64 * jj + key; return kp <= t && kp > t - 512; }
};
struct MobaMask {
  unsigned mq[2]; int tpos[2]; int ob; int w; int jj; bool s0, s1;
  DI bool skip(int j) const { return j > 4 * ob + w; }
  DI void set(int j) { jj = j; const int jb = j >> 2; s0 = (mq[0] >> jb) & 1u; s1 = (mq[1] >> jb) & 1u; }
  DI int mode(int j) const { const int jb = j >> 2; return jb < ob ? (__all(s0 && s1) ? 0 : 1) : ((j - 4 * ob == w) ? 2 : 0); }
  DI bool live(int qi) const { return qi == 0 ? s0 : s1; }
  DI bool vis(int qi, int key) const { return 64 * jj + key <= tpos[qi]; }
};

DI void load_q(const AttnLds& L, const act_t* qrow, int qi, int lane) {
  const int h = lane >> 5;
#pragma unroll
  for (int ks = 0; ks < 4; ++ks) {
    RawA r;
    bf16x8 hi, lo;
    raw_load(qrow + ks * 16 + h * 8, r);
    raw_frag<false>(r, hi, lo);
    *(bf16x8*)&L.Qs[((qi * 4 + ks) * 64 + lane) * 8] = hi;
  }
}

DI size_t late_row(int b, int t) { asm volatile("" : "+v"(t)); return (size_t)b * SEQ + t; }
DI void nsa_item(const Params& p, unsigned char* smem, int b, int qt) {
  int tid_ = threadIdx.x;
  asm volatile("" : "+v"(tid_));
  const int tid = tid_, lane = tid & 63, wave = __builtin_amdgcn_readfirstlane(tid >> 6), r32 = lane & 31, h = lane >> 5;
  AttnLds L;
  L.Ks = (bf16_t*)smem; L.Vs = (bf16_t*)(smem + KS_BYTES); L.Qs = (bf16_t*)(smem + KS_BYTES + VS_BYTES + wave * (QS_BYTES / 4));
  float* impsum = (float*)(smem + KS_BYTES + VS_BYTES + QS_BYTES);
  unsigned long long* selmask = (unsigned long long*)(impsum + 32 * 64);
  float* scr = (float*)(selmask + 32);
  const int t0 = qt * 32, cur = t0 >> 6, t = t0 + r32;
  const size_t tokrow = (size_t)b * SEQ + t;
#pragma unroll
  for (int qi = 0; qi < 2; ++qi) {
    const int hd = 2 * wave + qi;
    load_q(L, p.proj + tokrow * NP + hd * 64, qi, lane);
  }
  FlashSt st;
  flash_init(st);
  const int ncmp = (t0 >> 10) + 1;
  {
    CmpMask mg; mg.t = t; mg.t0 = t0; mg.jj = 0;
    run_branch(L, p.kc + (size_t)b * 256 * 64, 64, p.vcT + (size_t)b * 64 * 256, 256, 0, ncmp, mg, st, tid);
  }
  float mc[2], il[2];
#pragma unroll
  for (int qi = 0; qi < 2; ++qi) {
    const float lt = pair_sum32(st.l[qi]);
    const float inv = lt > 0.f ? 1.0f / lt : 0.f;
    mc[qi] = st.m[qi]; il[qi] = inv;
    const size_t row = late_row(b, t);
    const float gs = ldf(p.proj + row * NP + SLOT_GATE * 64 + 6 * wave + 3 * qi) * inv;
    float* dst = p.mixacc + row * 512 + (2 * wave + qi) * 64;
#pragma unroll
    for (int dt = 0; dt < 2; ++dt)
#pragma unroll
      for (int g = 0; g < 4; ++g)
        *(float4*)(dst + dt * 32 + 8 * g + 4 * h) = make_float4(st.o[qi][dt][4 * g] * gs, st.o[qi][dt][4 * g + 1] * gs, st.o[qi][dt][4 * g + 2] * gs, st.o[qi][dt][4 * g + 3] * gs);
  }
  unsigned long long msk;
  if (cur >= 16) {
    __syncthreads();
    for (int i = tid; i < 32 * 64; i += NTHREADS) impsum[i] = 0.f;
    RawA rkn[2];
    stage_k_load(p.kc + (size_t)b * 256 * 64, 64, tid, rkn);
    for (int j = 0; j < ncmp; ++j) {
      __syncthreads();
      stage_k_store(L, tid, rkn);
      __syncthreads();
      if (j + 1 < ncmp) stage_k_load(p.kc + (size_t)b * 256 * 64 + (size_t)(j + 1) * 64 * 64, 64, tid, rkn);
      f32x16 s[2][2];
      qk_tile(L, s, lane);
#pragma unroll
      for (int kt = 0; kt < 2; ++kt)
#pragma unroll
        for (int g = 0; g < 4; ++g) {
          float v4 = 0.f, v3 = 0.f;
#pragma unroll
          for (int e = 0; e < 4; ++e) {
            const int i = 4 * g + e;
            const int n = 64 * j + kt * 32 + crow(i, h);
            float pv = 0.f;
            if (16 * n + 31 <= t) pv = __builtin_amdgcn_exp2f(s[kt][0][i] - mc[0]) * il[0] + __builtin_amdgcn_exp2f(s[kt][1][i] - mc[1]) * il[1];
            v4 += pv;
            if (e == 3) v3 = pv;
          }
          const int bin = 16 * j + 8 * kt + 2 * g + h;
          atomicAdd((int*)&impsum[r32 * 64 + bin], __float2int_rn(v4 * 16777216.0f));
          if (bin + 1 < 64) atomicAdd((int*)&impsum[r32 * 64 + bin + 1], __float2int_rn(v3 * 16777216.0f));
        }
    }
    __syncthreads();
    for (int tt = 0; tt < 8; ++tt) {
      const int tok = wave * 8 + tt;
      const int jb = lane;
      const bool valid = jb <= cur;
      const bool forced = valid && (jb == 0 || jb == cur || jb == cur - 1);
      const float sc = forced ? INFINITY : (valid ? (float)((const int*)impsum)[tok * 64 + jb] : -INFINITY);
      scr[wave * 64 + lane] = sc;
      __builtin_amdgcn_wave_barrier();
      __builtin_amdgcn_s_waitcnt(0xc07f);
      int rank = 0;
      for (int i = 0; i < 64; ++i) {
        const float o = scr[wave * 64 + i];
        rank += (o > sc || (o == sc && i < jb)) ? 1 : 0;
      }
      const unsigned long long m = __ballot(rank < 16 && valid);
      if (lane == 0) selmask[tok] = m;
      __builtin_amdgcn_wave_barrier();
    }
    __syncthreads();
    msk = selmask[r32];
  } else {
    msk = (2ull << cur) - 1ull;
  }
  flash_init(st);
  {
    SlcMask mg; mg.msk = msk; mg.cur = cur; mg.t = t; mg.jj = 0; mg.sel = false;
    run_branch(L, p.proj + (size_t)b * SEQ * NP + SLOT_KSLC * 64, NP, p.vT_slc + (size_t)b * 64 * SEQ, SEQ, 0, cur + 1, mg, st, tid);
  }
#pragma unroll
  for (int qi = 0; qi < 2; ++qi) {
    const float lt = pair_sum32(st.l[qi]);
    const size_t row = late_row(b, t);
    const float gs = ldf(p.proj + row * NP + SLOT_GATE * 64 + 6 * wave + 3 * qi + 1) * (lt > 0.f ? 1.0f / lt : 0.f);
    float* dst = p.mixacc + row * 512 + (2 * wave + qi) * 64;
#pragma unroll
    for (int dt = 0; dt < 2; ++dt)
#pragma unroll
      for (int g = 0; g < 4; ++g) {
        float4* q4 = (float4*)(dst + dt * 32 + 8 * g + 4 * h);
        float4 v = *q4;
        v.x += st.o[qi][dt][4 * g] * gs; v.y += st.o[qi][dt][4 * g + 1] * gs; v.z += st.o[qi][dt][4 * g + 2] * gs; v.w += st.o[qi][dt][4 * g + 3] * gs;
        *q4 = v;
      }
  }
  flash_init(st);
  {
    WinMask mg; mg.t = t; mg.t0 = t0; mg.jj = 0;
    const int jlo = t0 >= 511 ? (t0 - 511) >> 6 : 0;
    run_branch(L, p.proj + (size_t)b * SEQ * NP + SLOT_KWIN * 64, NP, p.vT_win + (size_t)b * 64 * SEQ, SEQ, jlo, cur + 1, mg, st, tid);
  }
#pragma unroll
  for (int qi = 0; qi < 2; ++qi) {
    const float lt = pair_sum32(st.l[qi]);
    const size_t row = late_row(b, t);
    const float gs = ldf(p.proj + row * NP + SLOT_GATE * 64 + 6 * wave + 3 * qi + 2) * (lt > 0.f ? 1.0f / lt : 0.f);
    const float* src = p.mixacc + row * 512 + (2 * wave + qi) * 64;
    act_t* dst = p.mix + row * DM + (2 * wave + qi) * 64;
#if ORACLE
#pragma unroll
    for (int dt = 0; dt < 2; ++dt)
#pragma unroll
      for (int g = 0; g < 4; ++g) {
        const float4 v = *(const float4*)(src + dt * 32 + 8 * g + 4 * h);
        st4(dst + dt * 32 + 8 * g + 4 * h, v.x + st.o[qi][dt][4 * g] * gs, v.y + st.o[qi][dt][4 * g + 1] * gs, v.z + st.o[qi][dt][4 * g + 2] * gs, v.w + st.o[qi][dt][4 * g + 3] * gs);
      }
#else
#pragma unroll
    for (int dt = 0; dt < 2; ++dt)
#pragma unroll
      for (int g = 0; g < 4; g += 2) {
        const float4 v = *(const float4*)(src + dt * 32 + 8 * g + 4 * h);
        const float4 w = *(const float4*)(src + dt * 32 + 8 * g + 8 + 4 * h);
        st_pair16(dst + dt * 32 + 8 * g, h, v.x + st.o[qi][dt][4 * g] * gs, v.y + st.o[qi][dt][4 * g + 1] * gs, v.z + st.o[qi][dt][4 * g + 2] * gs, v.w + st.o[qi][dt][4 * g + 3] * gs,
                  w.x + st.o[qi][dt][4 * g + 4] * gs, w.y + st.o[qi][dt][4 * g + 5] * gs, w.z + st.o[qi][dt][4 * g + 6] * gs, w.w + st.o[qi][dt][4 * g + 7] * gs);
      }
#endif
  }
}

DI void moba_item(const Params& p, unsigned char* smem, int b, int hd, int ob) {
  int tid_ = threadIdx.x;
  asm volatile("" : "+v"(tid_));
  const int tid = tid_, lane = tid & 63, wave = __builtin_amdgcn_readfirstlane(tid >> 6), r32 = lane & 31, h = lane >> 5;
  AttnLds L;
  L.Ks = (bf16_t*)smem; L.Vs = (bf16_t*)(smem + KS_BYTES); L.Qs = (bf16_t*)(smem + KS_BYTES + VS_BYTES + wave * (QS_BYTES / 4));
  float* km = (float*)(smem + KS_BYTES + VS_BYTES + QS_BYTES);
  unsigned* msel = (unsigned*)(km + 16 * 64);
  __syncthreads();
  {
    float kv[4];
#pragma unroll
    for (int q = 0; q < 4; ++q) kv[q] = p.kmean[(size_t)(b * 8 + hd) * 16 * 64 + q * NTHREADS + tid];
#pragma unroll
    for (int q = 0; q < 4; ++q) km[q * NTHREADS + tid] = kv[q];
  }
  __syncthreads();
  {
    const act_t* qrow = p.proj + ((size_t)b * SEQ + ob * 256 + tid) * NP + (SLOT_MQ + hd) * 64;
    float gsc[16];
#pragma unroll
    for (int n = 0; n < 16; ++n) gsc[n] = 0.f;
    for (int dc = 0; dc < 64; dc += 8) {
      RawA r;
      raw_load(qrow + dc, r);
      float qv[8];
      raw_floats(r, qv);
#pragma unroll
      for (int n = 0; n < 16; ++n) {
        if (n < ob) {
#pragma unroll
          for (int j = 0; j < 8; ++j) gsc[n] += qv[j] * km[n * 64 + dc + j];
        }
      }
    }
    unsigned m = 0;
#pragma unroll
    for (int r = 0; r < 3; ++r) {
      float best = -INFINITY; int bi = -1;
#pragma unroll
      for (int n = 0; n < 16; ++n) {
        const bool ok = (n < ob) && !((m >> n) & 1u);
        if (ok && gsc[n] > best) { best = gsc[n]; bi = n; }
      }
      if (bi >= 0) m |= (1u << bi);
    }
    msel[tid] = m;
  }
  __syncthreads();
  MobaMask mg;
  mg.ob = ob; mg.w = wave; mg.jj = 0; mg.s0 = mg.s1 = false;
#pragma unroll
  for (int qi = 0; qi < 2; ++qi) {
    const int tl = 64 * wave + 32 * qi + r32;
    mg.mq[qi] = msel[tl];
    mg.tpos[qi] = ob * 256 + tl;
    load_q(L, p.proj + ((size_t)b * SEQ + ob * 256 + tl) * NP + (SLOT_MQ + hd) * 64, qi, lane);
  }
  FlashSt st;
  flash_init(st);
  run_branch(L, p.proj + (size_t)b * SEQ * NP + (SLOT_MK + hd) * 64, NP, p.vT_moba + (size_t)(b * 8 + hd) * 64 * SEQ, SEQ, 0, 4 * ob + 4, mg, st, tid);
#pragma unroll
  for (int qi = 0; qi < 2; ++qi) {
    const float lt = pair_sum32(st.l[qi]);
    const float inv = lt > 0.f ? 1.0f / lt : 0.f;
    act_t* dst = p.mix + ((size_t)b * SEQ + mg.tpos[qi]) * DM + 512 + hd * 64;
#if ORACLE
#pragma unroll
    for (int dt = 0; dt < 2; ++dt)
#pragma unroll
      for (int g = 0; g < 4; ++g)
        st4(dst + dt * 32 + 8 * g + 4 * h, st.o[qi][dt][4 * g] * inv, st.o[qi][dt][4 * g + 1] * inv, st.o[qi][dt][4 * g + 2] * inv, st.o[qi][dt][4 * g + 3] * inv);
#else
#pragma unroll
    for (int dt = 0; dt < 2; ++dt)
#pragma unroll
      for (int g = 0; g < 4; g += 2)
        st_pair16(dst + dt * 32 + 8 * g, h, st.o[qi][dt][4 * g] * inv, st.o[qi][dt][4 * g + 1] * inv, st.o[qi][dt][4 * g + 2] * inv, st.o[qi][dt][4 * g + 3] * inv,
                  st.o[qi][dt][4 * g + 4] * inv, st.o[qi][dt][4 * g + 5] * inv, st.o[qi][dt][4 * g + 6] * inv, st.o[qi][dt][4 * g + 7] * inv);
#endif
  }
}

DI void phase3(const Params& p, unsigned char* smem) {
  int& s_item = *(int*)(smem + SMEM_BYTES);
  for (;;) {
    __syncthreads();
    if (threadIdx.x == 0) s_item = atomicAdd(&p.ctr[0], 1);
    __syncthreads();
    const int n = __builtin_amdgcn_readfirstlane(s_item);
    if (n >= 1024) break;
    nsa_item(p, smem, n & 7, 127 - (n >> 3));
  }
  for (;;) {
    __syncthreads();
    if (threadIdx.x == 0) s_item = atomicAdd(&p.ctr[1], 1);
    __syncthreads();
    const int n = __builtin_amdgcn_readfirstlane(s_item);
    if (n >= 1024) break;
    moba_item(p, smem, (n & 63) >> 3, n & 7, 15 - (n >> 6));
  }
}

DI void phase4(const Params& p, unsigned char* smem) {
  const int tid = threadIdx.x, lane = tid & 63, wave = __builtin_amdgcn_readfirstlane(tid >> 6), wm = wave >> 1, wn = wave & 1, r32 = lane & 31, h = lane >> 5;
  const int vbid = (blockIdx.x & 7) * (gridDim.x >> 3) + (blockIdx.x >> 3);
  for (int tile = vbid; tile < 256 * 8; tile += gridDim.x) {
    const int mt = tile >> 3, nt = tile & 7, t0 = mt * 128, b = mt >> 5;
    AF_rows<act_t> af; af.src = p.mix + (size_t)t0 * DM; af.ld = DM;
    BT16 bp; bp.w = p.woutT; bp.wlo = p.woutTl; bp.ldk = DM; bp.n0 = nt * 128;
    f32x16 acc[2][2];
#if ORACLE
    gemm_core<kSplit, 0, AF_rows<act_t>, BT16, true>(smem, DM, af, bp, acc);
#else
    { AP_rows ap; ap.src = af.src; ap.ld = DM; gemm_core_gg<0>(smem, DM, ap, p.woutT, DM, nt * 128, acc); }
#endif
    {
      float* T = (float*)smem;
#pragma unroll 1
      for (int pass = 0; pass < 2; ++pass) {
        if (wm == pass) {
#pragma unroll
          for (int mi = 0; mi < 2; ++mi)
#pragma unroll
            for (int ni = 0; ni < 2; ++ni)
#pragma unroll
              for (int i = 0; i < 16; ++i) T[(mi * 32 + crow(i, h)) * 132 + wn * 64 + ni * 32 + r32] = acc[mi][ni][i];
        }
        __syncthreads();
        {
          const int cc = (tid & 31) * 4, r0 = tid >> 5;
          const float4 gt = *(const float4*)(p.mod + b * 6144 + 2048 + nt * 128 + cc);
          float4 xv[8];
#pragma unroll
          for (int q = 0; q < 8; ++q) xv[q] = *(const float4*)(p.x + (size_t)(t0 + pass * 64 + r0 + 8 * q) * DM + nt * 128 + cc);
#pragma unroll
          for (int q = 0; q < 8; ++q) {
            const int row = r0 + 8 * q;
            const float4 v = *(const float4*)&T[row * 132 + cc];
            __builtin_nontemporal_store(make_f32x4(xv[q].x + gt.x * v.x, xv[q].y + gt.y * v.y, xv[q].z + gt.z * v.z, xv[q].w + gt.w * v.w),
                                        (f32x4*)(p.hres + (size_t)(t0 + pass * 64 + row) * DM + nt * 128 + cc));
          }
        }
        __syncthreads();
      }
    }
  }
}

#if ORACLE
DI void phase5pre(const Params& p) {
  const int tid = otid(), lane = tid & 63, wave = __builtin_amdgcn_readfirstlane(tid >> 6);
  const int gw = blockIdx.x * 4 + wave, nw = gridDim.x * 4;
  for (int tok = gw; tok < NT; tok += nw) {
    const int b = tok >> 12;
    const float* xr = p.hres + (size_t)tok * DM;
    float4 xv[4];
    float ss = 0.f;
#pragma unroll
    for (int j = 0; j < 4; ++j) {
      xv[j] = *(const float4*)(xr + lane * 4 + 256 * j);
      ss += xv[j].x * xv[j].x + xv[j].y * xv[j].y + xv[j].z * xv[j].z + xv[j].w * xv[j].w;
    }
    ss = wave_sum(ss);
    const float rsv = 1.0f / sqrtf(ss * (1.0f / DM) + 1e-6f);
#pragma unroll
    for (int j = 0; j < 4; ++j) {
      const int c = lane * 4 + 256 * j;
      const float4 g = *(const float4*)(p.g_ffn + c);
      const float4 sc = *(const float4*)(p.mod + b * 6144 + 4096 + c);
      const float4 sh = *(const float4*)(p.mod + b * 6144 + 3072 + c);
      const float v0 = xv[j].x * rsv * (g.x * (1.0f + sc.x)) + sh.x, v1 = xv[j].y * rsv * (g.y * (1.0f + sc.y)) + sh.y;
      const float v2 = xv[j].z * rsv * (g.z * (1.0f + sc.z)) + sh.z, v3 = xv[j].w * rsv * (g.w * (1.0f + sc.w)) + sh.w;
      st4(p.h2 + (size_t)tok * DM + c, v0, v1, v2, v3);
#if !ORACLE
      const float h0 = bf2f(f2bf(v0)), h1 = bf2f(f2bf(v1)), h2_ = bf2f(f2bf(v2)), h3 = bf2f(f2bf(v3));
      st4(p.h2lo + (size_t)tok * DM + c, v0 - h0, v1 - h1, v2 - h2_, v3 - h3);
#endif
    }
  }
#if ORACLE
  {
    float4* ya = (float4*)p.yacc;
    const size_t n4 = (size_t)NT * DM / 4;
    for (size_t i = (size_t)blockIdx.x * NTHREADS + tid; i < n4; i += (size_t)gridDim.x * NTHREADS) ya[i] = make_float4(0, 0, 0, 0);
  }
#endif
}
#else
DI void phase5pre(const Params& p) {
  const int tid = otid(), lane = tid & 63, wave = __builtin_amdgcn_readfirstlane(tid >> 6);
  const int gw = blockIdx.x * 4 + wave, nw = gridDim.x * 4;
  for (int tok = gw; tok < NT; tok += nw) {
    const int b = tok >> 12;
    const float* xr = p.hres + (size_t)tok * DM;
    float xv[16];
    float ss = 0.f;
#pragma unroll
    for (int j = 0; j < 2; ++j) {
      const float4 a0 = *(const float4*)(xr + lane * 8 + 512 * j), a1 = *(const float4*)(xr + lane * 8 + 512 * j + 4);
      float* xx = xv + 8 * j;
      xx[0] = a0.x; xx[1] = a0.y; xx[2] = a0.z; xx[3] = a0.w; xx[4] = a1.x; xx[5] = a1.y; xx[6] = a1.z; xx[7] = a1.w;
#pragma unroll
      for (int q = 0; q < 8; ++q) ss += xx[q] * xx[q];
    }
    ss = wave_sum(ss);
    const float rsv = 1.0f / sqrtf(ss * (1.0f / DM) + 1e-6f);
#pragma unroll
    for (int j = 0; j < 2; ++j) {
      const int c = lane * 8 + 512 * j;
      float o[8], ol[8];
#pragma unroll
      for (int hh = 0; hh < 2; ++hh) {
        const float4 g = *(const float4*)(p.g_ffn + c + 4 * hh);
        const float4 sc = *(const float4*)(p.mod + b * 6144 + 4096 + c + 4 * hh);
        const float4 sh = *(const float4*)(p.mod + b * 6144 + 3072 + c + 4 * hh);
        const float* xx = xv + 8 * j + 4 * hh;
        o[4 * hh] = xx[0] * rsv * (g.x * (1.0f + sc.x)) + sh.x; o[4 * hh + 1] = xx[1] * rsv * (g.y * (1.0f + sc.y)) + sh.y;
        o[4 * hh + 2] = xx[2] * rsv * (g.z * (1.0f + sc.z)) + sh.z; o[4 * hh + 3] = xx[3] * rsv * (g.w * (1.0f + sc.w)) + sh.w;
      }
#pragma unroll
      for (int q = 0; q < 8; ++q) ol[q] = o[q] - bf2f(f2bf(o[q]));
      st8bf(p.h2 + (size_t)tok * DM + c, o);
      st8bf(p.h2lo + (size_t)tok * DM + c, ol);
    }
  }
}
#endif

DI void phase5a(const Params& p, unsigned char* smem) {
  const int tid = threadIdx.x, lane = tid & 63, wave = __builtin_amdgcn_readfirstlane(tid >> 6), wm = wave >> 1, wn = wave & 1, r32 = lane & 31, h = lane >> 5;
  for (int tile = blockIdx.x; tile < 512; tile += gridDim.x) {
    const int mt = tile >> 1, nt = tile & 1, t0 = mt * 128;
#if ORACLE
    AF_rows<act_t> af; af.src = p.h2 + (size_t)t0 * DM; af.ld = DM;
#else
    AF_hl af; af.hi = p.h2 + (size_t)t0 * DM; af.lo = p.h2lo + (size_t)t0 * DM; af.ld = DM;
#endif
    BT16 bp; bp.w = p.wrT; bp.wlo = p.wrTl; bp.ldk = DM; bp.n0 = nt * 128;
    f32x16 acc[2][2];
    gemm_core<true, 0>(smem, DM, af, bp, acc);
#pragma unroll
    for (int mi = 0; mi < 2; ++mi)
#pragma unroll
      for (int ni = 0; ni < 2; ++ni)
#pragma unroll
        for (int i = 0; i < 16; ++i) {
          const int r = t0 + wm * 64 + mi * 32 + crow(i, h);
          p.scores[(size_t)r * 256 + nt * 128 + wn * 64 + ni * 32 + r32] = sigmoidf_(acc[mi][ni][i]);
        }
  }
}

DI void phase5b(const Params& p, unsigned char* smem) {
  const int tid = otid(), lane = tid & 63, wave = __builtin_amdgcn_readfirstlane(tid >> 6);
  int* hist = (int*)smem;
  int* ebase = hist + 256;
  int* sel = ebase + 256;
  __syncthreads();
  hist[tid] = 0;
  __syncthreads();
  const int gw = blockIdx.x * 4 + wave, nw = gridDim.x * 4;
  const float4 bias4 = *(const float4*)(p.router_bias + 4 * lane);
  float4 s4n = make_float4(0.f, 0.f, 0.f, 0.f);
  if (gw < NT) s4n = *(const float4*)(p.scores + (size_t)gw * 256 + 4 * lane);
  int it = 0;
  for (int tok = gw; tok < NT; tok += nw, ++it) {
    const float4 s4 = s4n;
    if (tok + nw < NT) s4n = *(const float4*)(p.scores + (size_t)(tok + nw) * 256 + 4 * lane);
    const float sc0 = s4.x, sc1 = s4.y, sc2 = s4.z, sc3 = s4.w;
    const float b0 = sc0 + bias4.x, b1 = sc1 + bias4.y, b2 = sc2 + bias4.z, b3 = sc3 + bias4.w;
    float m1 = fmaxf(b0, b1), m2 = fminf(b0, b1);
    { const float n1 = fmaxf(m1, b2), n2 = fmaxf(fminf(m1, b2), m2); m1 = n1; m2 = n2; }
    { const float n1 = fmaxf(m1, b3), n2 = fmaxf(fminf(m1, b3), m2); m1 = n1; m2 = n2; }
    { const float o1 = dppf<DPP_XOR1>(m1), o2 = dppf<DPP_XOR1>(m2); const float n1 = fmaxf(m1, o1), n2 = fmaxf(fminf(m1, o1), fmaxf(m2, o2)); m1 = n1; m2 = n2; }
    { const float o1 = dppf<DPP_XOR2>(m1), o2 = dppf<DPP_XOR2>(m2); const float n1 = fmaxf(m1, o1), n2 = fmaxf(fminf(m1, o1), fmaxf(m2, o2)); m1 = n1; m2 = n2; }
    { const float o1 = dppf<DPP_HMIRROR>(m1), o2 = dppf<DPP_HMIRROR>(m2); const float n1 = fmaxf(m1, o1), n2 = fmaxf(fminf(m1, o1), fmaxf(m2, o2)); m1 = n1; m2 = n2; }
    const float gs = m1 + m2;
    const int g = lane >> 3;
    int rank = 0;
#pragma unroll
    for (int gg = 0; gg < 8; ++gg) {
      const float v = rlf(gs, gg * 8);
      rank += (v > gs || (v == gs && gg < g)) ? 1 : 0;
    }
    const bool gsel = rank < 4;
    float c0 = gsel ? b0 : -INFINITY, c1 = gsel ? b1 : -INFINITY, c2 = gsel ? b2 : -INFINITY, c3 = gsel ? b3 : -INFINITY;
    int mye = 0; float mys = 0.f, ssum = 0.f;
#pragma unroll
    for (int r = 0; r < 8; ++r) {
      float lb = c0; int lj = 0;
      if (c1 > lb) { lb = c1; lj = 1; }
      if (c2 > lb) { lb = c2; lj = 2; }
      if (c3 > lb) { lb = c3; lj = 3; }
      float w = lb;
      w = fmaxf(w, dppf<DPP_XOR1>(w)); w = fmaxf(w, dppf<DPP_XOR2>(w)); w = fmaxf(w, dppf<DPP_HMIRROR>(w)); w = fmaxf(w, dppf<DPP_MIRROR>(w));
      const float wmax = fmaxf(fmaxf(rlf(w, 0), rlf(w, 16)), fmaxf(rlf(w, 32), rlf(w, 48)));
      const unsigned long long owners = __ballot(lb == wmax);
      const int ol = __builtin_amdgcn_readfirstlane((int)__ffsll((long long)owners) - 1);
      const float mine = lj == 0 ? sc0 : (lj == 1 ? sc1 : (lj == 2 ? sc2 : sc3));
      const int oj = __builtin_amdgcn_readlane(lj, ol);
      const float ws = rlf(mine, ol);
      if (lane == ol) {
        if (oj == 0) c0 = -INFINITY; else if (oj == 1) c1 = -INFINITY; else if (oj == 2) c2 = -INFINITY; else c3 = -INFINITY;
      }
      ssum += ws;
      if (lane == r) { mye = 4 * ol + oj; mys = ws; }
    }
    if (lane < 8) {
      const float w = mys / ssum * 2.5f;
      const int lr = atomicAdd(&hist[mye], 1);
      sel[(it * 4 + wave) * 8 + lane] = mye | (lr << 16);
      p.selw[tok * NSLOT + lane] = w;
    }
  }
  __syncthreads();
  {
    const int hcnt = hist[tid];
    ebase[tid] = hcnt > 0 ? atomicAdd(&p.cnt[tid * CNT_STRIDE], hcnt) : 0;
  }
  __syncthreads();
  const int nit = it;
  for (int idx = tid; idx < nit * 32; idx += NTHREADS) {
    const int v = sel[idx], e = v & 0xffff, lr = v >> 16;
    const int i2 = idx >> 5, w2 = (idx >> 3) & 3, k2 = idx & 7;
    const int tok2 = (blockIdx.x * 4 + w2) + i2 * nw;
    p.list[(size_t)e * CAP + ebase[e] + lr] = tok2 * NSLOT + k2;
  }
}

struct AF_gather {
  typedef typename RawOf<act_t>::type Raw;
  const act_t* h2; const int* rowtok;
  DI void load(int row, int k, Raw& r) const {
    const int tk = max(rowtok[row], 0);
    raw_load(h2 + (size_t)tk * DM + k, r);
  }
  DI void cvt(const Raw& r, int row, int k, bf16x8& hi, bf16x8& lo) const { raw_frag<kSplit>(r, hi, lo); }
};

#define BIG6X (!ORACLE)
#if !ORACLE
constexpr int G4_STAGE = 24576;
template <int NMAP>
DI void gemm_compute_g4(const unsigned char* As, const unsigned char* Bs, f32x16 (&acc)[4][2], int wm, int wn, int r32, int h) {
  const int sw = (r32 >> 2) & 3;
#pragma unroll 1
  for (int ks = 0; ks < 2; ++ks) {
    const int pc = ((ks * 2 + h) ^ sw) << 4;
    bf16x8 a[4], b[2];
#pragma unroll
    for (int mi = 0; mi < 4; ++mi) a[mi] = *(const bf16x8*)(As + (wm * 128 + mi * 32 + r32) * 64 + pc);
#pragma unroll
    for (int ni = 0; ni < 2; ++ni) {
      const int nrow = (NMAP == 0) ? (wn * 64 + ni * 32) : (ni == 0 ? wn * 32 : 64 + wn * 32);
      b[ni] = *(const bf16x8*)(Bs + (nrow + r32) * 64 + pc);
    }
#pragma unroll
    for (int ni = 0; ni < 2; ++ni)
#pragma unroll
      for (int mi = 0; mi < 4; ++mi) acc[mi][ni] = MFMA(a[mi], b[ni], acc[mi][ni]);
  }
}
constexpr int G4_BOFF = 2 * 16384, G4_BSUPER = 16384, G4_LDS = G4_BOFF + 2 * G4_BSUPER;
template <int NMAP, class AP>
DI void gemm_core_gf4(unsigned char* smem, int K, const AP& ap, const float* wa, const float* wb, int ldb, int ca, int cb, f32x16 (&acc)[4][2]) {
  const int tid = otid(), lane = tid & 63, wave = __builtin_amdgcn_readfirstlane(tid >> 6), wm = wave >> 1, wn = wave & 1, r32 = lane & 31, h = lane >> 5;
#pragma unroll
  for (int mi = 0; mi < 4; ++mi)
#pragma unroll
    for (int ni = 0; ni < 2; ++ni)
#pragma unroll
      for (int i = 0; i < 16; ++i) acc[mi][ni][i] = 0.f;
  const int grow = tid >> 2, gc = ((tid & 3) ^ ((tid >> 4) & 3)) * 8;
  const bf16_t* a0 = ap.rowptr(grow) + gc;
  const bf16_t* a1 = ap.rowptr(grow + 64) + gc;
  const bf16_t* a2 = ap.rowptr(grow + 128) + gc;
  const bf16_t* a3 = ap.rowptr(grow + 192) + gc;
  const int c4 = tid & 15, bh = (tid >> 4) & 1, kq = tid >> 5;
  const float* bbase = (bh ? (wb + cb) : (wa + ca)) + 4 * c4 + (size_t)(8 * kq) * ldb;
  const int bo = (kq >> 2) * 8192;
  const int brow = bh * 64 + 4 * c4;
  const unsigned wbase = __builtin_amdgcn_readfirstlane(lds_off(smem) + wave * 1024);
  float4 rb[8];
  auto bload = [&](int k0) {
#pragma unroll
    for (int j = 0; j < 8; ++j) rb[j] = *(const float4*)(bbase + (size_t)(k0 + j) * ldb);
  };
  auto bstore = [&](unsigned char* Bs) {
    bf16x8 hi, lo;
    float v[8];
#pragma unroll
    for (int j = 0; j < 8; ++j) v[j] = rb[j].x;
    cvt8<false>(v, hi, lo); *(bf16x8*)(Bs + bo + swz_off(brow, kq & 3)) = hi;
#pragma unroll
    for (int j = 0; j < 8; ++j) v[j] = rb[j].y;
    cvt8<false>(v, hi, lo); *(bf16x8*)(Bs + bo + swz_off(brow + 1, kq & 3)) = hi;
#pragma unroll
    for (int j = 0; j < 8; ++j) v[j] = rb[j].z;
    cvt8<false>(v, hi, lo); *(bf16x8*)(Bs + bo + swz_off(brow + 2, kq & 3)) = hi;
#pragma unroll
    for (int j = 0; j < 8; ++j) v[j] = rb[j].w;
    cvt8<false>(v, hi, lo); *(bf16x8*)(Bs + bo + swz_off(brow + 3, kq & 3)) = hi;
  };
  glds16_asm(a0, wbase); glds16_asm(a1, wbase + 4096); glds16_asm(a2, wbase + 8192); glds16_asm(a3, wbase + 12288);
  bload(0);
  bstore(smem + G4_BOFF);
  asm volatile("s_waitcnt vmcnt(0)" ::: "memory");
  __syncthreads();
  const int nS = K >> 6;
#pragma unroll 1
  for (int S = 0; S < nS; ++S) {
    const bool more = S + 1 < nS;
    const int k0 = S * 64;
    unsigned char* Bcur = smem + G4_BOFF + (S & 1) * G4_BSUPER;
    { const unsigned d2 = wbase + 16384;
      glds16_asm(a0 + k0 + 32, d2); glds16_asm(a1 + k0 + 32, d2 + 4096); glds16_asm(a2 + k0 + 32, d2 + 8192); glds16_asm(a3 + k0 + 32, d2 + 12288); }
    if (more) bload(k0 + 64);
    gemm_compute_g4<NMAP>(smem, Bcur, acc, wm, wn, r32, h);
    if (more) asm volatile("s_waitcnt vmcnt(8)" ::: "memory");
    else asm volatile("s_waitcnt vmcnt(0)" ::: "memory");
    __syncthreads();
    if (more) bstore(smem + G4_BOFF + ((S + 1) & 1) * G4_BSUPER);
    if (more) { glds16_asm(a0 + k0 + 64, wbase); glds16_asm(a1 + k0 + 64, wbase + 4096); glds16_asm(a2 + k0 + 64, wbase + 8192); glds16_asm(a3 + k0 + 64, wbase + 12288); }
    gemm_compute_g4<NMAP>(smem + 16384, Bcur + 8192, acc, wm, wn, r32, h);
    asm volatile("s_waitcnt vmcnt(0)" ::: "memory");
    __syncthreads();
  }
}

DI int expert_tile_prefix(const Params& p, int* pre, int tid) {
  const int lane = tid & 63, wave = tid >> 6;
  int* wsum = pre + 260;
  __syncthreads();
  const int mine = (p.cnt[tid * CNT_STRIDE] + 255) >> 8;
  int v = mine;
#pragma unroll
  for (int o = 1; o < 64; o <<= 1) { const int u = __shfl_up(v, o); if (lane >= o) v += u; }
  if (lane == 63) wsum[wave] = v;
  __syncthreads();
  int off = 0;
#pragma unroll
  for (int w = 0; w < 3; ++w) off += (w < wave) ? wsum[w] : 0;
  pre[tid] = off + v - mine;
  if (tid == NEXP - 1) { pre[NEXP] = off + v; pre[NEXP + 1] = off + v + 128; }
  __syncthreads();
  return __builtin_amdgcn_readfirstlane(pre[NEXP + 1]);
}
DI void expert_tile_lookup(const int* pre, int ti, int& e, int& mt) {
  int lo = 0, hi = NEXP;
  while (lo < hi) { const int mid = (lo + hi + 1) >> 1; if (pre[mid] <= ti) lo = mid; else hi = mid - 1; }
  e = __builtin_amdgcn_readfirstlane(lo); mt = __builtin_amdgcn_readfirstlane(ti - pre[lo]);
}

DI void phase6a(const Params& p, unsigned char* smem) {
  const int tid = otid(), lane = tid & 63, wave = __builtin_amdgcn_readfirstlane(tid >> 6), wm = wave >> 1, wn = wave & 1, r32 = lane & 31, h = lane >> 5;
  constexpr int TBL = G4_LDS;
  int* pre = (int*)(smem + TBL);
  int* rowtok = pre + 260;
  const int ntiles = expert_tile_prefix(p, pre, tid);
  const int total = ntiles * 4;
  const int vbid = (blockIdx.x & 7) * (gridDim.x >> 3) + (blockIdx.x >> 3);
  int e_n = 0, mt_n = 0, tk_n = -1;
  auto fetch_rows = [&](int it) {
    expert_tile_lookup(pre, it >> 2, e_n, mt_n);
    tk_n = -1;
    if (e_n < NEXP) {
      const int idx = mt_n * 256 + tid;
      if (idx < p.cnt[e_n * CNT_STRIDE]) tk_n = p.list[(size_t)e_n * CAP + idx] / NSLOT;
    } else {
      tk_n = mt_n * 256 + tid;
    }
  };
  if (vbid < total) fetch_rows(vbid);
  for (int item = vbid; item < total; item += gridDim.x) {
    const int ti = item >> 2, nt = item & 3;
    const int e = e_n;
    __syncthreads();
    rowtok[tid] = tk_n;
    __syncthreads();
    if (item + (int)gridDim.x < total) fetch_rows(item + gridDim.x);
    const float* wg = e < NEXP ? p.w_eg + (size_t)e * DM * 256 : p.w_sg;
    const float* wu = e < NEXP ? p.w_eu + (size_t)e * DM * 256 : p.w_su;
    f32x16 acc[4][2];
    { AP_gather ap; ap.h2 = p.h2; ap.rowtok = rowtok; gemm_core_gf4<1>(smem, DM, ap, wg, wu, 256, nt * 64, nt * 64, acc); }
    bf16_t* T = (bf16_t*)smem;
#pragma unroll
    for (int mi = 0; mi < 4; ++mi)
#pragma unroll
      for (int i = 0; i < 16; ++i)
        T[(wm * 128 + mi * 32 + crow(i, h)) * 72 + wn * 32 + r32] = f2bf(siluf_fast(acc[mi][0][i]) * acc[mi][1][i]);
    __syncthreads();
    bf16_t* dstb = p.abuf + (size_t)ti * 256 * 256 + nt * 64;
    { auto rp = [&](int r) { return dstb + (size_t)r * 256; }; epi_flush_bf16<8, decltype(rp), true>(T, 72, 256, rp); }
  }
}

DI void phase6b(const Params& p, unsigned char* smem) {
  const int tid = otid(), lane = tid & 63, wave = __builtin_amdgcn_readfirstlane(tid >> 6), wm = wave >> 1, wn = wave & 1, r32 = lane & 31, h = lane >> 5;
  constexpr int TBL = SMEM_BYTES - 3328;
  static_assert(TBL >= 256 * 136 * 2 && TBL >= G4_LDS, "6b LDS plan");
  int* pre = (int*)(smem + TBL);
  int* rowslot = pre + 260;
  float* roww = (float*)(rowslot + 256);
  const int ntiles = expert_tile_prefix(p, pre, tid);
  const int total = ntiles * 8;
  const int vbid = (blockIdx.x & 7) * (gridDim.x >> 3) + (blockIdx.x >> 3);
  int e_n = 0, mt_n = 0, slot_n = -1; float w_n = 0.f;
  auto fetch_rows = [&](int it) {
    expert_tile_lookup(pre, it >> 3, e_n, mt_n);
    slot_n = -1; w_n = 0.f;
    if (e_n < NEXP) {
      const int idx = mt_n * 256 + tid;
      if (idx < p.cnt[e_n * CNT_STRIDE]) { slot_n = p.list[(size_t)e_n * CAP + idx]; w_n = p.selw[slot_n]; }
    } else {
      slot_n = (mt_n * 256 + tid) * NSLOT + 8; w_n = 1.0f;
    }
  };
  if (vbid < total) fetch_rows(vbid);
  for (int item = vbid; item < total; item += gridDim.x) {
    const int ti = item >> 3, nt = item & 7;
    const int e = e_n;
    __syncthreads();
    rowslot[tid] = slot_n; roww[tid] = w_n;
    __syncthreads();
    if (item + (int)gridDim.x < total) fetch_rows(item + gridDim.x);
    const float* wd = e < NEXP ? p.w_ed + (size_t)e * 256 * DM : p.w_sd;
    f32x16 acc[4][2];
    { AP_rows ap; ap.src = p.abuf + (size_t)ti * 256 * 256; ap.ld = 256; gemm_core_gf4<0>(smem, 256, ap, wd, wd, DM, nt * 128, nt * 128 + 64, acc); }
    bf16_t* T = (bf16_t*)smem;
    bf16_t* yb = p.yslots + nt * 128;
#pragma unroll 1
    for (int pass = 0; pass < 2; ++pass) {
      int ps = pass;
      asm volatile("" : "+s"(ps));
      if (wm == ps) {
#pragma unroll
        for (int mi = 0; mi < 4; ++mi)
#pragma unroll
          for (int i = 0; i < 16; ++i) {
            const int rl = pass * 128 + mi * 32 + crow(i, h);
            const float w = roww[rl];
#pragma unroll
            for (int ni = 0; ni < 2; ++ni) T[rl * 136 + wn * 64 + ni * 32 + r32] = f2bf(acc[mi][ni][i] * w);
          }
      }
    }
    __syncthreads();
#pragma unroll 1
    for (int hf = 0; hf < 2; ++hf) {
      auto rp = [&](int r) { const int slot = rowslot[hf * 128 + r]; return slot >= 0 ? yb + (size_t)slot * DM : (bf16_t*)nullptr; };
      epi_flush_bf16<16, decltype(rp), true>(T + hf * 128 * 136, 136, 128, rp);
    }
  }
}
#else
DI void phase6(const Params& p, unsigned char* smem) {
  const int tid = threadIdx.x, lane = tid & 63, wave = __builtin_amdgcn_readfirstlane(tid >> 6), wm = wave >> 1, wn = wave & 1, r32 = lane & 31, h = lane >> 5;
  int* pre = (int*)(smem + GEMM_LDS);
  int* rowslot = pre + 260;
  int* rowtok = rowslot + 128;
  float* roww = (float*)(rowtok + 128);
  __syncthreads();
  if (tid == 0) {
    int s = 0;
    for (int e = 0; e < NEXP; ++e) { pre[e] = s; s += (p.cnt[e * CNT_STRIDE] + 127) >> 7; }
    pre[NEXP] = s; s += 256; pre[NEXP + 1] = s;
  }
  __syncthreads();
  const int total = __builtin_amdgcn_readfirstlane(pre[NEXP + 1]);
  act_t* ab = p.abuf + (size_t)blockIdx.x * 128 * 256;
  const int vbid = (blockIdx.x & 7) * (gridDim.x >> 3) + (blockIdx.x >> 3);
  for (int item = vbid; item < total; item += gridDim.x) {
    int lo = 0, hi = NEXP;
    while (lo < hi) { const int mid = (lo + hi + 1) >> 1; if (pre[mid] <= item) lo = mid; else hi = mid - 1; }
    const int e = __builtin_amdgcn_readfirstlane(lo), mt = __builtin_amdgcn_readfirstlane(item - pre[lo]);
    __syncthreads();
    if (tid < 128) {
      int slot = -1; float w = 0.f;
      if (e < NEXP) {
        const int idx = mt * 128 + tid;
        if (idx < p.cnt[e * CNT_STRIDE]) { slot = p.list[(size_t)e * CAP + idx]; w = p.selw[slot]; }
      } else {
        slot = (mt * 128 + tid) * NSLOT + 8; w = 1.0f;
      }
      rowslot[tid] = slot; rowtok[tid] = slot >= 0 ? slot / NSLOT : -1; roww[tid] = w;
    }
    __syncthreads();
    const float* wg = e < NEXP ? p.w_eg + (size_t)e * DM * 256 : p.w_sg;
    const float* wu = e < NEXP ? p.w_eu + (size_t)e * DM * 256 : p.w_su;
    const float* wd = e < NEXP ? p.w_ed + (size_t)e * 256 * DM : p.w_sd;
#pragma unroll 1
    for (int nt = 0; nt < 4; ++nt) {
      AF_gather af; af.h2 = p.h2; af.rowtok = rowtok;
      BF32 bp; bp.wa = wg; bp.wb = wu; bp.ldb = 256; bp.ca = nt * 64; bp.cb = nt * 64;
      f32x16 acc[2][2];
#if ORACLE
      gemm_core<kSplit, 1>(smem, DM, af, bp, acc);
#else
      { AP_gather ap; ap.h2 = p.h2; ap.rowtok = rowtok; gemm_core_gf<1>(smem, DM, ap, wg, wu, 256, nt * 64, nt * 64, acc); }
#endif
#if ORACLE
#pragma unroll
      for (int mi = 0; mi < 2; ++mi)
#pragma unroll
        for (int i = 0; i < 16; ++i) {
          const int r = wm * 64 + mi * 32 + crow(i, h);
          const int cc = nt * 64 + wn * 32 + r32;
          st1(ab + (size_t)r * 256 + cc, siluf_(acc[mi][0][i]) * acc[mi][1][i]);
        }
#else
      {
        bf16_t* T = (bf16_t*)smem;
#pragma unroll
        for (int mi = 0; mi < 2; ++mi)
#pragma unroll
          for (int i = 0; i < 16; ++i)
            T[(wm * 64 + mi * 32 + crow(i, h)) * 72 + wn * 32 + r32] = f2bf(siluf_(acc[mi][0][i]) * acc[mi][1][i]);
        __syncthreads();
        bf16_t* dstb = ab + nt * 64;
        epi_flush_bf16<8>(T, 72, 128, [&](int r) { return dstb + (size_t)r * 256; });
        __syncthreads();
      }
#endif
    }
    __threadfence_block();
    __syncthreads();
#pragma unroll 1
    for (int nt = 0; nt < 8; ++nt) {
      AF_rows<act_t> af; af.src = ab; af.ld = 256;
      BF32 bp; bp.wa = wd; bp.wb = wd; bp.ldb = DM; bp.ca = nt * 128; bp.cb = nt * 128 + 64;
      f32x16 acc[2][2];
#if ORACLE
      gemm_core<kSplit, 0>(smem, 256, af, bp, acc);
#else
      { AP_rows ap; ap.src = ab; ap.ld = 256; gemm_core_gf<0>(smem, 256, ap, wd, wd, DM, nt * 128, nt * 128 + 64, acc); }
#endif
#if ORACLE
#pragma unroll
      for (int mi = 0; mi < 2; ++mi)
#pragma unroll
        for (int i = 0; i < 16; ++i) {
          const int r = wm * 64 + mi * 32 + crow(i, h);
          const int slot = rowslot[r];
          if (slot >= 0) {
            const float w = roww[r];
#pragma unroll
            for (int ni = 0; ni < 2; ++ni) {
              const int n = nt * 128 + wn * 64 + ni * 32 + r32;
              atomicAdd((int*)&p.yacc[(size_t)rowtok[r] * DM + n], __float2int_rn(acc[mi][ni][i] * w * 16777216.0f));
            }
          }
        }
#else
      {
        bf16_t* T = (bf16_t*)smem;
#pragma unroll
        for (int mi = 0; mi < 2; ++mi)
#pragma unroll
          for (int i = 0; i < 16; ++i) {
            const int r = wm * 64 + mi * 32 + crow(i, h);
            const float w = roww[r];
#pragma unroll
            for (int ni = 0; ni < 2; ++ni) T[r * 136 + wn * 64 + ni * 32 + r32] = f2bf(acc[mi][ni][i] * w);
          }
        __syncthreads();
        bf16_t* yb = p.yslots + nt * 128;
        epi_flush_bf16<16>(T, 136, 128, [&](int r) { const int slot = rowslot[r]; return slot >= 0 ? yb + (size_t)slot * DM : (bf16_t*)nullptr; });
        __syncthreads();
      }
#endif
    }
  }
}

#endif

#if ORACLE
DI void phase7(const Params& p) {
  const int tid = otid(), lane = tid & 63, wave = __builtin_amdgcn_readfirstlane(tid >> 6);
  const int gw = blockIdx.x * 4 + wave, nw = gridDim.x * 4;
  for (int tok = gw; tok < NT; tok += nw) {
    const int b = tok >> 12;
    float v[16];
    float ss = 0.f;
#pragma unroll
    for (int j = 0; j < 4; ++j) {
      const int col = lane * 4 + 256 * j;
      const float4 hr = *(const float4*)(p.hres + (size_t)tok * DM + col);
      float y[4] = {0.f, 0.f, 0.f, 0.f};
#if ORACLE
      {
        const int4 yi = *(const int4*)(p.yacc + (size_t)tok * DM + col);
        y[0] = (float)yi.x * (1.0f / 16777216.0f); y[1] = (float)yi.y * (1.0f / 16777216.0f); y[2] = (float)yi.z * (1.0f / 16777216.0f); y[3] = (float)yi.w * (1.0f / 16777216.0f);
      }
#else
#pragma unroll
      for (int k = 0; k < NSLOT; ++k) {
        float t4[4];
        ld4f(p.yslots + ((size_t)tok * NSLOT + k) * DM + col, t4);
        y[0] += t4[0]; y[1] += t4[1]; y[2] += t4[2]; y[3] += t4[3];
      }
#endif
      const float4 gt = *(const float4*)(p.mod + b * 6144 + 5120 + col);
      v[4 * j] = hr.x + gt.x * y[0]; v[4 * j + 1] = hr.y + gt.y * y[1]; v[4 * j + 2] = hr.z + gt.z * y[2]; v[4 * j + 3] = hr.w + gt.w * y[3];
      ss += v[4 * j] * v[4 * j] + v[4 * j + 1] * v[4 * j + 1] + v[4 * j + 2] * v[4 * j + 2] + v[4 * j + 3] * v[4 * j + 3];
    }
    ss = wave_sum(ss);
    const float r = 1.0f / sqrtf(ss * (1.0f / DM) + 1e-6f);
#pragma unroll
    for (int j = 0; j < 4; ++j) {
      const int col = lane * 4 + 256 * j;
      const float4 g = *(const float4*)(p.g_final + col);
      __builtin_nontemporal_store(make_f32x4(v[4 * j] * r * g.x, v[4 * j + 1] * r * g.y, v[4 * j + 2] * r * g.z, v[4 * j + 3] * r * g.w), (f32x4*)(p.out + (size_t)tok * DM + col));
    }
  }
}
#else
DI void phase7(const Params& p) {
  const int tid = otid(), lane = tid & 63, wave = __builtin_amdgcn_readfirstlane(tid >> 6);
  const int gw = blockIdx.x * 4 + wave, nw = gridDim.x * 4;
  for (int tok = gw; tok < NT; tok += nw) {
    const int b = tok >> 12;
    float v[16];
    float ss = 0.f;
#pragma unroll
    for (int j = 0; j < 2; ++j) {
      const int col = lane * 8 + 512 * j;
      const float4 hr0 = *(const float4*)(p.hres + (size_t)tok * DM + col), hr1 = *(const float4*)(p.hres + (size_t)tok * DM + col + 4);
      float y[8] = {0.f, 0.f, 0.f, 0.f, 0.f, 0.f, 0.f, 0.f};
#pragma unroll
      for (int k = 0; k < NSLOT; ++k) {
        const u32x4 u = *(const u32x4*)(p.yslots + ((size_t)tok * NSLOT + k) * DM + col);
#pragma unroll
        for (int q = 0; q < 4; ++q) { y[2 * q] += __uint_as_float(u[q] << 16); y[2 * q + 1] += __uint_as_float(u[q] & 0xffff0000u); }
      }
      const float4 gt0 = *(const float4*)(p.mod + b * 6144 + 5120 + col), gt1 = *(const float4*)(p.mod + b * 6144 + 5120 + col + 4);
      float* vv = v + 8 * j;
      vv[0] = hr0.x + gt0.x * y[0]; vv[1] = hr0.y + gt0.y * y[1]; vv[2] = hr0.z + gt0.z * y[2]; vv[3] = hr0.w + gt0.w * y[3];
      vv[4] = hr1.x + gt1.x * y[4]; vv[5] = hr1.y + gt1.y * y[5]; vv[6] = hr1.z + gt1.z * y[6]; vv[7] = hr1.w + gt1.w * y[7];
#pragma unroll
      for (int q = 0; q < 8; ++q) ss += vv[q] * vv[q];
    }
    ss = wave_sum(ss);
    const float r = 1.0f / sqrtf(ss * (1.0f / DM) + 1e-6f);
#pragma unroll
    for (int j = 0; j < 2; ++j) {
      const int col = lane * 8 + 512 * j;
      const float4 g0 = *(const float4*)(p.g_final + col), g1 = *(const float4*)(p.g_final + col + 4);
      const float* vv = v + 8 * j;
      __builtin_nontemporal_store(make_f32x4(vv[0] * r * g0.x, vv[1] * r * g0.y, vv[2] * r * g0.z, vv[3] * r * g0.w), (f32x4*)(p.out + (size_t)tok * DM + col));
      __builtin_nontemporal_store(make_f32x4(vv[4] * r * g1.x, vv[5] * r * g1.y, vv[6] * r * g1.z, vv[7] * r * g1.w), (f32x4*)(p.out + (size_t)tok * DM + col + 4));
    }
  }
}
#endif

struct KArgs { const float* in[23]; float* out; unsigned char* ws; };
struct Carver {
  unsigned char* ws; size_t off;
  __host__ __device__ __forceinline__ unsigned char* take(size_t bytes) { unsigned char* q = ws + off; off = (off + bytes + 255) & ~(size_t)255; return q; }
};
__host__ __device__ __forceinline__ size_t carve(Params& p, unsigned char* ws) {
  Carver c{ws, 0};
  p.mod = (float*)c.take(8 * 6144 * 4);
  p.ropec = (float*)c.take(4096 * 32 * 8);
  p.ropes = nullptr;
  p.kmean = (float*)c.take(8 * 8 * 16 * 64 * 4);
  p.cnt = (int*)c.take((size_t)(NEXP + 1) * CNT_STRIDE * 4);
  p.ctr = (int*)c.take(256);
  p.bar = (unsigned*)c.take(XCD_BAR_WORDS * 4);
  p.selw = (float*)c.take((size_t)NT * NSLOT * 4);
  p.winT = (bf16_t*)c.take((size_t)2560 * LDH * 2); p.winTl = (bf16_t*)c.take((size_t)2560 * LDH * 2);
  p.woutT = (bf16_t*)c.take((size_t)1024 * 1024 * 2); p.woutTl = (bf16_t*)c.take((size_t)1024 * 1024 * 2);
  p.wrT = (bf16_t*)c.take((size_t)256 * 1024 * 2); p.wrTl = (bf16_t*)c.take((size_t)256 * 1024 * 2);
  p.w1kT = (bf16_t*)c.take((size_t)256 * 2048 * 2); p.w1kTl = (bf16_t*)c.take((size_t)256 * 2048 * 2);
  p.w1vT = (bf16_t*)c.take((size_t)256 * 2048 * 2); p.w1vTl = (bf16_t*)c.take((size_t)256 * 2048 * 2);
  p.w2kT = (bf16_t*)c.take((size_t)128 * 256 * 2); p.w2kTl = (bf16_t*)c.take((size_t)128 * 256 * 2);
  p.w2vT = (bf16_t*)c.take((size_t)128 * 256 * 2); p.w2vTl = (bf16_t*)c.take((size_t)128 * 256 * 2);
  p.hres = (float*)c.take((size_t)NT * DM * 4);
  p.h2 = (act_t*)c.take((size_t)NT * DM * sizeof(act_t));
  p.list = (int*)c.take((size_t)NEXP * CAP * 4);
  const size_t uoff = c.off;
  p.proj = (act_t*)c.take((size_t)(NT + 64) * NP * sizeof(act_t));
  p.vT_slc = (act_t*)c.take((size_t)80 * 64 * SEQ * sizeof(act_t));
  p.vT_win = p.vT_slc + (size_t)8 * 64 * SEQ;
  p.vT_moba = p.vT_slc + (size_t)16 * 64 * SEQ;
  p.hid = nullptr;
  p.hidp = (float*)c.take((size_t)4 * 2 * 2048 * 256 * 4);
  p.kc = (act_t*)c.take((size_t)8 * 256 * 64 * sizeof(act_t));
  p.vcT = (act_t*)c.take((size_t)8 * 64 * 256 * sizeof(act_t));
  p.mixacc = (float*)c.take((size_t)NT * 512 * 4);
  p.mix = (act_t*)c.take((size_t)NT * LDH * sizeof(act_t));
  p.h1 = p.mix;
  const size_t end_a = c.off;
  c.off = uoff;
#if ORACLE
  p.abuf = (act_t*)c.take((size_t)512 * 128 * 256 * sizeof(act_t));
  p.scores = (float*)c.take((size_t)NT * 256 * 4);
  p.yacc = (float*)c.take((size_t)NT * DM * 4);
  p.yslots = nullptr;
  p.h2lo = (bf16_t*)c.take((size_t)NT * DM * 2);
#else
  p.abuf = (act_t*)c.take((size_t)1408 * 256 * 256 * sizeof(act_t));
  p.scores = (float*)p.abuf;
  p.yacc = nullptr;
  p.yslots = (act_t*)c.take((size_t)NT * NSLOT * DM * sizeof(act_t));
  p.h2lo = (bf16_t*)p.yslots;
#endif
  const size_t end_b = c.off;
  return end_a > end_b ? end_a : end_b;
}
typedef const __attribute__((address_space(4))) KArgs* KArgsPtr;
DI Params expand() {
  KArgsPtr ka = (KArgsPtr)__builtin_amdgcn_kernarg_segment_ptr();
  asm volatile("" : "+s"(ka));
  Params p;
  p.x = ka->in[0]; p.c = ka->in[1]; p.w_ada = ka->in[2]; p.b_ada = ka->in[3]; p.g_attn = ka->in[4]; p.w_in = ka->in[5];
  p.pos_k = ka->in[6]; p.w1_k = ka->in[7]; p.w2_k = ka->in[8]; p.pos_v = ka->in[9]; p.w1_v = ka->in[10]; p.w2_v = ka->in[11];
  p.w_out = ka->in[12]; p.g_ffn = ka->in[13]; p.w_router = ka->in[14]; p.router_bias = ka->in[15];
  p.w_eg = ka->in[16]; p.w_eu = ka->in[17]; p.w_ed = ka->in[18]; p.w_sg = ka->in[19]; p.w_su = ka->in[20]; p.w_sd = ka->in[21]; p.g_final = ka->in[22];
  p.out = ka->out;
  unsigned char* ws = ka->ws;
  carve(p, ws);
  return p;
}

__global__ void __launch_bounds__(NTHREADS, ORACLE ? 1 : 2) fwd_megakernel(KArgs ka_unused) {
  __shared__ __attribute__((aligned(16))) unsigned char smem[SMEM_BYTES + 32];
  uint4* xb_words = (uint4*)(smem + SMEM_BYTES + 16);
  if (threadIdx.x == 0) *xb_words = make_uint4(0u, 0u, 0u, 0u);
  __syncthreads();
  XcdBarrier xb;
  { const Params p = expand(); xb = xcd_barrier_post(p.bar, (volatile LAS unsigned*)xb_words); }
  { const Params p = expand(); phase0<0>(p, smem); }
  xcd_barrier(xb);
  { const Params p = expand(); phase0<1>(p, smem); phase0b(p); }
  xcd_barrier(xb);
  { const Params p = expand(); phase1(p, smem); }
  xcd_barrier(xb);
  { const Params p = expand(); phase2a(p, smem); }
  xcd_barrier(xb);
  { const Params p = expand(); phase2b(p, smem); }
  xcd_barrier(xb);
  { const Params p = expand(); phase3(p, smem); }
  xcd_barrier(xb);
  { const Params p = expand(); phase4(p, smem); }
  xcd_barrier(xb);
  { const Params p = expand(); phase5pre(p); }
  xcd_barrier(xb);
  { const Params p = expand(); phase5a(p, smem); }
  xcd_barrier(xb);
  { const Params p = expand(); phase5b(p, smem); }
  xcd_barrier(xb);
#if BIG6X
  { const Params p = expand(); phase6a(p, smem); }
  xcd_barrier(xb);
  { const Params p = expand(); phase6b(p, smem); }
#else
  { const Params p = expand(); phase6(p, smem); }
#endif
  xcd_barrier(xb);
  { const Params p = expand(); phase7(p); }
}

extern "C" void kernel_launch(void* const* d_in, const int* in_sizes, int n_in, void* d_out, int out_size, void* d_ws, size_t ws_size,
                              hipStream_t stream) {
  static int grid_blocks = 0;
  if (!grid_blocks) {
    int dev = 0, cus = 0, per_cu = 0;
    hipGetDevice(&dev);
    hipDeviceGetAttribute(&cus, hipDeviceAttributeMultiprocessorCount, dev);
    hipOccupancyMaxActiveBlocksPerMultiprocessor(&per_cu, fwd_megakernel, NTHREADS, 0);
    if (per_cu > 2) per_cu = 2;
    if (per_cu < 1) per_cu = 1;
    grid_blocks = cus * per_cu;
  }
  KArgs ka{};
  for (int i = 0; i < 23; ++i) ka.in[i] = (const float*)d_in[i];
  ka.out = (float*)d_out;
  ka.ws = (unsigned char*)d_ws;
  Params p{};
  const size_t need = carve(p, ka.ws);
  if (need > ws_size) { fprintf(stderr, "kernel_launch: workspace too small: need %zu have %zu\n", need, ws_size); return; }
  if (hipMemsetAsync(p.bar, 0, XCD_BAR_WORDS * 4, stream) != hipSuccess) { fprintf(stderr, "kernel_launch: memset of barrier words failed\n"); return; }
  void* args[] = {&ka};
  hipError_t e = hipLaunchCooperativeKernel((void*)fwd_megakernel, dim3(grid_blocks), dim3(NTHREADS), args, 0, stream);
  if (e != hipSuccess) fprintf(stderr, "cooperative launch failed: %s (grid %d)\n", hipGetErrorString(e), grid_blocks);
}
```

```cpp
#include <hip/hip_runtime.h>
#include <hip/hip_cooperative_groups.h>
#include <cstdio>
#include <cstdint>
namespace cg = cooperative_groups;

#ifndef ORACLE
#define ORACLE 0
#endif
#ifndef DBG
#define DBG 0
#endif
#define DI __device__ __forceinline__

typedef unsigned short bf16_t;
typedef __attribute__((ext_vector_type(8))) short bf16x8;
typedef __attribute__((ext_vector_type(4))) short s16x4;
typedef __attribute__((ext_vector_type(16))) float f32x16;
typedef __attribute__((ext_vector_type(4))) unsigned int u32x4;

#if ORACLE
typedef float act_t;
constexpr bool kSplit = true;
#else
typedef bf16_t act_t;
constexpr bool kSplit = false;
#endif

constexpr int DM = 1024, NB = 8, SEQ = 4096, NT = NB * SEQ;
constexpr int INC = 2456;
constexpr int NP = 2496;
constexpr int SLOT_KCMP = 8, SLOT_VCMP = 9, SLOT_KSLC = 10, SLOT_VSLC = 11, SLOT_KWIN = 12, SLOT_VWIN = 13, SLOT_GATE = 14;
constexpr int SLOT_MQ = 15, SLOT_MK = 23, SLOT_MV = 31;
constexpr int NEXP = 256, CAP = 32768, NSLOT = 9;
constexpr int SMEM_BYTES = 77 * 1024;
constexpr int NTHREADS = 256;
constexpr float QSCALE = 0.125f * 1.44269504088896340736f;
constexpr int CNT_STRIDE = 64;
constexpr int LDH = 1056;

struct Params {
  const float *x, *c, *w_ada, *b_ada, *g_attn, *w_in, *pos_k, *w1_k, *w2_k, *pos_v, *w1_v, *w2_v, *w_out, *g_ffn,
      *w_router, *router_bias, *w_eg, *w_eu, *w_ed, *w_sg, *w_su, *w_sd, *g_final;
  float* out;
  float *mod, *ropec, *ropes, *kmean, *mixacc, *hres, *scores, *selw, *yacc, *hidp;
  act_t *proj, *vT_slc, *vT_win, *vT_moba, *hid, *kc, *vcT, *mix, *h2, *abuf, *yslots, *h1;
  bf16_t *h2lo;
  bf16_t *winT, *winTl, *woutT, *woutTl, *wrT, *wrTl, *w1kT, *w1kTl, *w1vT, *w1vTl, *w2kT, *w2kTl, *w2vT, *w2vTl;
  int *cnt, *list, *ctr;
  unsigned* bar;
};

DI int otid() { int t = threadIdx.x; asm volatile("" : "+v"(t)); return t; }
typedef float f32x4 __attribute__((ext_vector_type(4)));
typedef unsigned u32x2 __attribute__((ext_vector_type(2)));
DI f32x4 make_f32x4(float a, float b, float c, float d) { f32x4 v = {a, b, c, d}; return v; }
DI bf16_t f2bf(float x) { __bf16 b = (__bf16)x; return __builtin_bit_cast(bf16_t, b); }
DI float bf2f(bf16_t h) { return __uint_as_float(((unsigned)h) << 16); }
DI float sigmoidf_(float x) { return 1.0f / (1.0f + __expf(-x)); }
DI float siluf_(float x) { return x / (1.0f + __expf(-x)); }
DI float sigmoidf_fast(float x) { return __builtin_amdgcn_rcpf(1.0f + __expf(-x)); }
DI float siluf_fast(float x) { return x * __builtin_amdgcn_rcpf(1.0f + __expf(-x)); }
DI int crow(int i, int h) { return (i & 3) + 8 * (i >> 2) + 4 * h; }
#define MFMA(a, b, c) __builtin_amdgcn_mfma_f32_32x32x16_bf16((a), (b), (c), 0, 0, 0)

struct RawF { float4 a, b; };
struct RawH { uint4 u; };
template <class T> struct RawOf;
template <> struct RawOf<float> { typedef RawF type; };
template <> struct RawOf<bf16_t> { typedef RawH type; };

DI void raw_load(const float* p, RawF& r) { r.a = *(const float4*)p; r.b = *(const float4*)(p + 4); }
DI void raw_load(const bf16_t* p, RawH& r) { r.u = *(const uint4*)p; }
DI void raw_zero(RawF& r) { r.a = make_float4(0, 0, 0, 0); r.b = r.a; }
DI void raw_zero(RawH& r) { r.u = make_uint4(0, 0, 0, 0); }
DI void raw_floats(const RawF& r, float (&v)[8]) { v[0] = r.a.x; v[1] = r.a.y; v[2] = r.a.z; v[3] = r.a.w; v[4] = r.b.x; v[5] = r.b.y; v[6] = r.b.z; v[7] = r.b.w; }
DI void raw_floats(const RawH& r, float (&v)[8]) {
  v[0] = __uint_as_float(r.u.x << 16); v[1] = __uint_as_float(r.u.x & 0xffff0000u);
  v[2] = __uint_as_float(r.u.y << 16); v[3] = __uint_as_float(r.u.y & 0xffff0000u);
  v[4] = __uint_as_float(r.u.z << 16); v[5] = __uint_as_float(r.u.z & 0xffff0000u);
  v[6] = __uint_as_float(r.u.w << 16); v[7] = __uint_as_float(r.u.w & 0xffff0000u);
}
template <bool SPLIT> DI void cvt8(const float (&v)[8], bf16x8& hi, bf16x8& lo) {
#pragma unroll
  for (int j = 0; j < 8; ++j) {
    bf16_t hh = f2bf(v[j]);
    hi[j] = (short)hh;
    if (SPLIT) lo[j] = (short)f2bf(v[j] - bf2f(hh)); else lo[j] = 0;
  }
}
template <bool SPLIT> DI void raw_frag(const RawF& r, bf16x8& hi, bf16x8& lo) { float v[8]; raw_floats(r, v); cvt8<SPLIT>(v, hi, lo); }
template <bool SPLIT> DI void raw_frag(const RawH& r, bf16x8& hi, bf16x8& lo) { hi = __builtin_bit_cast(bf16x8, r.u); lo = bf16x8{0, 0, 0, 0, 0, 0, 0, 0}; }

DI void st1(float* p, float v) { *p = v; }
DI void st1(bf16_t* p, float v) { *p = f2bf(v); }
DI void st4(float* p, float a, float b, float c, float d) { *(float4*)p = make_float4(a, b, c, d); }
DI void st4(bf16_t* p, float a, float b, float c, float d) {
  uint2 u;
  u.x = (unsigned)f2bf(a) | ((unsigned)f2bf(b) << 16);
  u.y = (unsigned)f2bf(c) | ((unsigned)f2bf(d) << 16);
  *(uint2*)p = u;
}
DI void st8(float* p, const float (&v)[8]) { *(float4*)p = make_float4(v[0], v[1], v[2], v[3]); *(float4*)(p + 4) = make_float4(v[4], v[5], v[6], v[7]); }
DI void st8(bf16_t* p, const float (&v)[8]) {
  uint4 u;
  u.x = (unsigned)f2bf(v[0]) | ((unsigned)f2bf(v[1]) << 16);
  u.y = (unsigned)f2bf(v[2]) | ((unsigned)f2bf(v[3]) << 16);
  u.z = (unsigned)f2bf(v[4]) | ((unsigned)f2bf(v[5]) << 16);
  u.w = (unsigned)f2bf(v[6]) | ((unsigned)f2bf(v[7]) << 16);
  *(uint4*)p = u;
}
DI float ldf(const float* p) { return *p; }
DI float ldf(const bf16_t* p) { return bf2f(*p); }
DI void ld4f(const float* p, float (&v)[4]) { float4 a = *(const float4*)p; v[0] = a.x; v[1] = a.y; v[2] = a.z; v[3] = a.w; }
DI void ld4f(const bf16_t* p, float (&v)[4]) {
  uint2 u = *(const uint2*)p;
  v[0] = __uint_as_float(u.x << 16); v[1] = __uint_as_float(u.x & 0xffff0000u);
  v[2] = __uint_as_float(u.y << 16); v[3] = __uint_as_float(u.y & 0xffff0000u);
}
DI unsigned pack2bf(float a, float b) { return (unsigned)f2bf(a) | ((unsigned)f2bf(b) << 16); }
DI void st8bf(bf16_t* p, const float (&v)[8]) {
  u32x4 u;
#pragma unroll
  for (int q = 0; q < 4; ++q) u[q] = pack2bf(v[2 * q], v[2 * q + 1]);
  *(u32x4*)p = u;
}
template <int CTRL> DI float dppf(float v) { return __int_as_float(__builtin_amdgcn_update_dpp(__float_as_int(v), __float_as_int(v), CTRL, 0xf, 0xf, false)); }
DI float rlf(float v, int l) { return __int_as_float(__builtin_amdgcn_readlane(__float_as_int(v), l)); }
constexpr int DPP_XOR1 = 0xB1, DPP_XOR2 = 0x4E, DPP_HMIRROR = 0x141, DPP_MIRROR = 0x140;
DI float row_max16(float v) {
  float r;
  asm volatile("s_nop 1\n\tv_max_f32_dpp %0, %1, %1 quad_perm:[1,0,3,2] row_mask:0xf bank_mask:0xf\n\t"
               "s_nop 1\n\tv_max_f32_dpp %0, %0, %0 quad_perm:[2,3,0,1] row_mask:0xf bank_mask:0xf\n\t"
               "s_nop 1\n\tv_max_f32_dpp %0, %0, %0 row_half_mirror row_mask:0xf bank_mask:0xf\n\t"
               "s_nop 1\n\tv_max_f32_dpp %0, %0, %0 row_mirror row_mask:0xf bank_mask:0xf\n\ts_nop 1"
               : "=&v"(r) : "v"(v));
  return r;
}
DI float wave_sum(float v) {
  v += dppf<DPP_XOR1>(v); v += dppf<DPP_XOR2>(v); v += dppf<DPP_HMIRROR>(v); v += dppf<DPP_MIRROR>(v);
  return (rlf(v, 0) + rlf(v, 16)) + (rlf(v, 32) + rlf(v, 48));
}
DI float pair_max32(float v) {
  const auto r = __builtin_amdgcn_permlane32_swap(__float_as_uint(v), __float_as_uint(v), false, false);
  float m; asm("v_max_f32 %0, %1, %2" : "=v"(m) : "v"(__uint_as_float(r[0])), "v"(__uint_as_float(r[1])));
  return m;
}
DI float pair_sum32(float v) {
  const auto r = __builtin_amdgcn_permlane32_swap(__float_as_uint(v), __float_as_uint(v), false, false);
  return __uint_as_float(r[0]) + __uint_as_float(r[1]);
}
DI void st_pair16(bf16_t* dst_g, int h, float a0, float a1, float a2, float a3, float b0, float b1, float b2, float b3) {
  const unsigned ax = pack2bf(a0, a1), ay = pack2bf(a2, a3), bx = pack2bf(b0, b1), by = pack2bf(b2, b3);
  const auto rx = __builtin_amdgcn_permlane32_swap(ax, bx, false, false);
  const auto ry = __builtin_amdgcn_permlane32_swap(ay, by, false, false);
  u32x4 v; v[0] = rx[0]; v[1] = ry[0]; v[2] = rx[1]; v[3] = ry[1];
  *(u32x4*)(dst_g + 8 * h) = v;
}


#define XB_TMO      128
#define XB_XCNT(j)  (256  + 64 * (j))
#define XB_XSUB(j)  (1280 + 64 * (j))
#define XB_XGEN(j)  (2304 + 64 * (j))
#define XB_TOP      3328
#define XB_TOPGEN   3392
#define XCD_BAR_WORDS 3456
#define XB_SPIN_CAP (1u << 20)
#define LAS __attribute__((address_space(3)))
DI unsigned xb_ld(unsigned* p) { return __hip_atomic_load(p, __ATOMIC_RELAXED, __HIP_MEMORY_SCOPE_AGENT); }
DI unsigned xb_add(unsigned* p, unsigned v) { return __hip_atomic_fetch_add(p, v, __ATOMIC_RELAXED, __HIP_MEMORY_SCOPE_AGENT); }
DI unsigned xb_xcc_id() { return (unsigned)__builtin_amdgcn_s_getreg((3 << 11) | 20) & 0xFu; }
#define XB_SPIN(cond, bar) do { unsigned _sp = 0; while (cond) { __builtin_amdgcn_s_sleep(1); \
    if ((++_sp & 255u) == 0u) { if (xb_ld(&(bar)[XB_TMO])) break; if (_sp > XB_SPIN_CAP) { atomicAdd(&(bar)[XB_TMO], 1u); break; } } } } while (0)
struct XcdBarrier { unsigned* bar; unsigned x; volatile LAS unsigned* st; };
DI XcdBarrier xcd_barrier_post(unsigned* bar, volatile LAS unsigned* st) {
  XcdBarrier b; b.bar = bar; b.x = xb_xcc_id(); b.st = st;
  if (threadIdx.x == 0) (void)xb_add(&bar[XB_XCNT(b.x)], 1u);
  return b;
}
DI void xcd_barrier_complete(unsigned* bar, unsigned x, unsigned& nloc, unsigned& nx) {
  const unsigned G = gridDim.x * gridDim.y * gridDim.z;
  unsigned sum, cnt, mine, sp = 0u;
  for (;;) {
    sum = 0u; cnt = 0u; mine = 0u;
#pragma unroll
    for (unsigned j = 0; j < 16; ++j) { const unsigned c = xb_ld(&bar[XB_XCNT(j)]); sum += c; cnt += (c > 0u) ? 1u : 0u; mine = (j == x) ? c : mine; }
    if (sum == G) break;
    __builtin_amdgcn_s_sleep(1);
    if ((++sp & 255u) == 0u) { if (xb_ld(&bar[XB_TMO])) break; if (sp > XB_SPIN_CAP) { atomicAdd(&bar[XB_TMO], 1u); break; } }
  }
  nloc = mine > 0u ? mine : 1u; nx = cnt > 0u ? cnt : 1u;
}
DI void xcd_barrier(const XcdBarrier& b) {
  asm volatile("s_waitcnt vmcnt(0)" ::: "memory");
  __syncthreads();
  if (threadIdx.x == 0) {
    unsigned* bar = b.bar;
    __builtin_amdgcn_s_waitcnt(0);
    unsigned nloc = b.st[0], nx = b.st[1];
    if (nloc == 0u) { xcd_barrier_complete(bar, b.x, nloc, nx); b.st[0] = nloc; b.st[1] = nx; }
    const unsigned old = xb_add(&bar[XB_XSUB(b.x)], 1u);
    const unsigned gen = old / nloc;
    if (old + 1u == (gen + 1u) * nloc) {
      __builtin_amdgcn_fence(__ATOMIC_RELEASE, "agent");
      asm volatile("s_waitcnt vmcnt(0)" ::: "memory");
      const unsigned og = xb_add(&bar[XB_TOP], 1u);
      const unsigned tg = og / nx;
      if (og + 1u == (tg + 1u) * nx) xb_add(&bar[XB_TOPGEN], 1u);
      else XB_SPIN(xb_ld(&bar[XB_TOPGEN]) == tg, bar);
      __builtin_amdgcn_fence(__ATOMIC_ACQUIRE, "agent");
      xb_add(&bar[XB_XGEN(b.x)], 1u);
      asm volatile("s_waitcnt vmcnt(0)" ::: "memory");
    } else {
      XB_SPIN(xb_ld(&bar[XB_XGEN(b.x)]) == gen, bar);
      __builtin_amdgcn_fence(__ATOMIC_ACQUIRE, "agent");
      asm volatile("s_waitcnt vmcnt(0)" ::: "memory");
    }
  }
  __syncthreads();
}

constexpr int LDA_S = 40;
constexpr int GEMM_STAGE = 2 * 128 * LDA_S * 2;
constexpr int GEMM_LDS = 2 * GEMM_STAGE;

struct BT16 {
  struct Raw { u32x4 r0, r1, l0, l1; };
  const bf16_t* w; const bf16_t* wlo; int ldk; int n0;
  template <bool SPLIT> DI void load(int k0, int tid, Raw& q) const {
    const size_t o = (size_t)(n0 + (tid >> 2)) * ldk + k0 + (tid & 3) * 8;
    const size_t o2 = o + (size_t)64 * ldk;
    q.r0 = *(const u32x4*)(w + o); q.r1 = *(const u32x4*)(w + o2);
    if (SPLIT) { q.l0 = *(const u32x4*)(wlo + o); q.l1 = *(const u32x4*)(wlo + o2); } else { q.l0 = q.r0; q.l1 = q.r1; }
  }
  template <bool SPLIT> DI void store(bf16_t* Bs, bf16_t* Bsl, int tid, const Raw& q) const {
    const int o = (tid >> 2) * LDA_S + (tid & 3) * 8;
    *(u32x4*)&Bs[o] = q.r0; *(u32x4*)&Bs[o + 64 * LDA_S] = q.r1;
    if (SPLIT) { *(u32x4*)&Bsl[o] = q.l0; *(u32x4*)&Bsl[o + 64 * LDA_S] = q.l1; }
  }
};
struct BF32 {
  struct Raw { float2 r[8]; };
  const float* wa; const float* wb; int ldb; int ca; int cb;
  template <bool SPLIT> DI void load(int k0, int tid, Raw& q) const {
    const int np = tid & 63, kk = tid >> 6;
    const float* base = (np < 32) ? (wa + ca + 2 * np) : (wb + cb + 2 * (np - 32));
    base += (size_t)(k0 + 8 * kk) * ldb;
#pragma unroll
    for (int j = 0; j < 8; ++j) q.r[j] = *(const float2*)(base + (size_t)j * ldb);
  }
  template <bool SPLIT> DI void store(bf16_t* Bs, bf16_t* Bsl, int tid, const Raw& q) const {
    const int np = tid & 63, kk = tid >> 6;
    float v0[8], v1[8];
#pragma unroll
    for (int j = 0; j < 8; ++j) { v0[j] = q.r[j].x; v1[j] = q.r[j].y; }
    bf16x8 hi, lo;
    cvt8<SPLIT>(v0, hi, lo);
    *(bf16x8*)&Bs[(2 * np) * LDA_S + 8 * kk] = hi;
    if (SPLIT) *(bf16x8*)&Bsl[(2 * np) * LDA_S + 8 * kk] = lo;
    cvt8<SPLIT>(v1, hi, lo);
    *(bf16x8*)&Bs[(2 * np + 1) * LDA_S + 8 * kk] = hi;
    if (SPLIT) *(bf16x8*)&Bsl[(2 * np + 1) * LDA_S + 8 * kk] = lo;
  }
};

template <bool SPLIT, class AF, class BP>
DI void gemm_stage_store(unsigned char* smem, int st, int k0, const AF& af, const BP& bp, const typename AF::Raw& ra0, const typename AF::Raw& ra1,
                         const typename BP::Raw& rb, int tid) {
  bf16_t* As = (bf16_t*)(smem + (SPLIT ? 0 : st * GEMM_STAGE));
  bf16_t* Bs = As + 128 * LDA_S;
  bf16_t* Asl = Bs + 128 * LDA_S;
  bf16_t* Bsl = Asl + 128 * LDA_S;
  const int arow0 = tid >> 2, akc = (tid & 3) * 8;
  bf16x8 hi, lo;
  af.cvt(ra0, arow0, k0 + akc, hi, lo);
  *(bf16x8*)&As[arow0 * LDA_S + akc] = hi;
  if (SPLIT) *(bf16x8*)&Asl[arow0 * LDA_S + akc] = lo;
  af.cvt(ra1, arow0 + 64, k0 + akc, hi, lo);
  *(bf16x8*)&As[(arow0 + 64) * LDA_S + akc] = hi;
  if (SPLIT) *(bf16x8*)&Asl[(arow0 + 64) * LDA_S + akc] = lo;
  bp.template store<SPLIT>(Bs, Bsl, tid, rb);
}
template <bool SPLIT, int NMAP>
DI void gemm_compute(const unsigned char* smem, int st, f32x16 (&acc)[2][2], int wm, int wn, int r32, int h) {
  const bf16_t* As = (const bf16_t*)(smem + (SPLIT ? 0 : st * GEMM_STAGE));
  const bf16_t* Bs = As + 128 * LDA_S;
  const bf16_t* Asl = Bs + 128 * LDA_S;
  const bf16_t* Bsl = Asl + 128 * LDA_S;
  if (!SPLIT) {
    bf16x8 a[2][2], b[2][2];
#pragma unroll
    for (int ks = 0; ks < 2; ++ks) {
#pragma unroll
      for (int mi = 0; mi < 2; ++mi) a[ks][mi] = *(const bf16x8*)&As[(wm * 64 + mi * 32 + r32) * LDA_S + ks * 16 + h * 8];
#pragma unroll
      for (int ni = 0; ni < 2; ++ni) {
        const int nrow = (NMAP == 0) ? (wn * 64 + ni * 32) : (ni == 0 ? wn * 32 : 64 + wn * 32);
        b[ks][ni] = *(const bf16x8*)&Bs[(nrow + r32) * LDA_S + ks * 16 + h * 8];
      }
    }
    asm volatile("s_waitcnt lgkmcnt(0)" ::: "memory");
    __builtin_amdgcn_sched_barrier(0);
    __builtin_amdgcn_s_setprio(1);
#pragma unroll
    for (int ks = 0; ks < 2; ++ks)
#pragma unroll
      for (int ni = 0; ni < 2; ++ni)
#pragma unroll
        for (int mi = 0; mi < 2; ++mi) acc[mi][ni] = MFMA(a[ks][mi], b[ks][ni], acc[mi][ni]);
    __builtin_amdgcn_s_setprio(0);
    __builtin_amdgcn_sched_barrier(0);
    return;
  }
#pragma unroll
  for (int ks = 0; ks < 2; ++ks) {
    bf16x8 a[2], al[2];
#pragma unroll
    for (int mi = 0; mi < 2; ++mi) {
      const int off = (wm * 64 + mi * 32 + r32) * LDA_S + ks * 16 + h * 8;
      a[mi] = *(const bf16x8*)&As[off];
      if (SPLIT) al[mi] = *(const bf16x8*)&Asl[off];
    }
#pragma unroll
    for (int ni = 0; ni < 2; ++ni) {
      const int nrow = (NMAP == 0) ? (wn * 64 + ni * 32) : (ni == 0 ? wn * 32 : 64 + wn * 32);
      const int off = (nrow + r32) * LDA_S + ks * 16 + h * 8;
      const bf16x8 b = *(const bf16x8*)&Bs[off];
      bf16x8 bl;
      if (SPLIT) bl = *(const bf16x8*)&Bsl[off];
#pragma unroll
      for (int mi = 0; mi < 2; ++mi) {
        acc[mi][ni] = MFMA(a[mi], b, acc[mi][ni]);
        if (SPLIT) {
          acc[mi][ni] = MFMA(al[mi], b, acc[mi][ni]);
          acc[mi][ni] = MFMA(a[mi], bl, acc[mi][ni]);
        }
      }
    }
  }
}

template <bool SPLIT, int NMAP, class AF, class BP, bool PF2 = false>
DI void gemm_core(unsigned char* smem, int K, const AF& af, const BP& bp, f32x16 (&acc)[2][2]) {
  const int tid = threadIdx.x, lane = tid & 63, wave = __builtin_amdgcn_readfirstlane(tid >> 6), wm = wave >> 1, wn = wave & 1, r32 = lane & 31, h = lane >> 5;
  const int arow0 = tid >> 2, akc = (tid & 3) * 8;
  typename AF::Raw ra0, ra1;
  typename BP::Raw rb;
#pragma unroll
  for (int mi = 0; mi < 2; ++mi)
#pragma unroll
    for (int ni = 0; ni < 2; ++ni)
#pragma unroll
      for (int i = 0; i < 16; ++i) acc[mi][ni][i] = 0.f;

  af.load(arow0, akc, ra0);
  af.load(arow0 + 64, akc, ra1);
  bp.template load<SPLIT>(0, tid, rb);
  if (!SPLIT && PF2) {
    typename AF::Raw rc0, rc1;
    typename BP::Raw rd;
    gemm_stage_store<SPLIT>(smem, 0, 0, af, bp, ra0, ra1, rb, tid);
    if (32 < K) { af.load(arow0, 32 + akc, ra0); af.load(arow0 + 64, 32 + akc, ra1); bp.template load<SPLIT>(32, tid, rb); }
    if (64 < K) { af.load(arow0, 64 + akc, rc0); af.load(arow0 + 64, 64 + akc, rc1); bp.template load<SPLIT>(64, tid, rd); }
    __syncthreads();
    for (int k0 = 0; k0 < K; k0 += 64) {
      gemm_compute<SPLIT, NMAP>(smem, 0, acc, wm, wn, r32, h);
      if (k0 + 32 < K) gemm_stage_store<SPLIT>(smem, 1, k0 + 32, af, bp, ra0, ra1, rb, tid);
      if (k0 + 96 < K) { af.load(arow0, k0 + 96 + akc, ra0); af.load(arow0 + 64, k0 + 96 + akc, ra1); bp.template load<SPLIT>(k0 + 96, tid, rb); }
      __syncthreads();
      if (k0 + 32 >= K) break;
      gemm_compute<SPLIT, NMAP>(smem, 1, acc, wm, wn, r32, h);
      if (k0 + 64 < K) gemm_stage_store<SPLIT>(smem, 0, k0 + 64, af, bp, rc0, rc1, rd, tid);
      if (k0 + 128 < K) { af.load(arow0, k0 + 128 + akc, rc0); af.load(arow0 + 64, k0 + 128 + akc, rc1); bp.template load<SPLIT>(k0 + 128, tid, rd); }
      __syncthreads();
    }
  } else if (!SPLIT) {
    gemm_stage_store<SPLIT>(smem, 0, 0, af, bp, ra0, ra1, rb, tid);
    __syncthreads();
    int cur = 0;
    for (int k0 = 0; k0 < K; k0 += 32) {
      const bool more = k0 + 32 < K;
      if (more) {
        af.load(arow0, k0 + 32 + akc, ra0);
        af.load(arow0 + 64, k0 + 32 + akc, ra1);
        bp.template load<SPLIT>(k0 + 32, tid, rb);
      }
      gemm_compute<SPLIT, NMAP>(smem, cur, acc, wm, wn, r32, h);
      if (more) gemm_stage_store<SPLIT>(smem, cur ^ 1, k0 + 32, af, bp, ra0, ra1, rb, tid);
      __syncthreads();
      cur ^= 1;
    }
  } else {
    for (int k0 = 0; k0 < K; k0 += 32) {
      __syncthreads();
      gemm_stage_store<SPLIT>(smem, 0, k0, af, bp, ra0, ra1, rb, tid);
      __syncthreads();
      if (k0 + 32 < K) {
        af.load(arow0, k0 + 32 + akc, ra0);
        af.load(arow0 + 64, k0 + 32 + akc, ra1);
        bp.template load<SPLIT>(k0 + 32, tid, rb);
      }
      gemm_compute<SPLIT, NMAP>(smem, 0, acc, wm, wn, r32, h);
    }
    __syncthreads();
  }
}


#if !ORACLE
constexpr int G_STAGE = 16384;
DI int swz_off(int row, int chunk) { return row * 64 + ((chunk ^ ((row >> 2) & 3)) << 4); }
DI void glds16(const bf16_t* gsrc, unsigned char* lds_dst) {
  __builtin_amdgcn_global_load_lds((const unsigned*)gsrc, (__attribute__((address_space(3))) unsigned*)lds_dst, 16, 0, 0);
}
struct AP_rows { const bf16_t* src; int ld; DI const bf16_t* rowptr(int row) const { return src + (size_t)row * ld; }
  DI const bf16_t* base() const { return src; } DI unsigned rowoff(int row) const { return (unsigned)(row * ld); } };
struct AP_gather { const bf16_t* h2; const int* rowtok; DI const bf16_t* rowptr(int row) const { return h2 + (size_t)max(rowtok[row], 0) * DM; }
  DI const bf16_t* base() const { return h2; } DI unsigned rowoff(int row) const { return (unsigned)(max(rowtok[row], 0) * DM); } };
DI void glds16_s(unsigned voff_bytes, const bf16_t* sbase_uniform, unsigned lds_dst_uniform) {
  asm volatile("s_mov_b32 m0, %2\n\ts_nop 0\n\tglobal_load_lds_dwordx4 %0, %1" :: "v"(voff_bytes), "s"(sbase_uniform), "s"(lds_dst_uniform) : "memory", "m0");
}

template <int NMAP, bool SWP = false>
DI void gemm_compute_g(const unsigned char* st, f32x16 (&acc)[2][2], int wm, int wn, int r32, int h) {
  const unsigned char* As = st;
  const unsigned char* Bs = st + 8192;
  const int sw = (r32 >> 2) & 3;
  bf16x8 a[2][2], b[2][2];
#pragma unroll
  for (int ks = 0; ks < 2; ++ks) {
    const int pc = ((ks * 2 + h) ^ sw) << 4;
#pragma unroll
    for (int mi = 0; mi < 2; ++mi) a[ks][mi] = *(const bf16x8*)(As + (wm * 64 + mi * 32 + r32) * 64 + pc);
#pragma unroll
    for (int ni = 0; ni < 2; ++ni) {
      const int nrow = (NMAP == 0) ? (wn * 64 + ni * 32) : (ni == 0 ? wn * 32 : 64 + wn * 32);
      b[ks][ni] = *(const bf16x8*)(Bs + (nrow + r32) * 64 + pc);
    }
  }
#pragma unroll
  for (int ks = 0; ks < 2; ++ks)
#pragma unroll
    for (int ni = 0; ni < 2; ++ni)
#pragma unroll
      for (int mi = 0; mi < 2; ++mi) acc[mi][ni] = SWP ? MFMA(b[ks][ni], a[ks][mi], acc[mi][ni]) : MFMA(a[ks][mi], b[ks][ni], acc[mi][ni]);
}

DI unsigned lds_off(const unsigned char* p) { return (unsigned)(size_t)(__attribute__((address_space(3))) const unsigned char*)p; }
DI void glds16_asm(const bf16_t* gsrc, unsigned lds_dst_uniform) {
  asm volatile("s_mov_b32 m0, %1\n\ts_nop 0\n\tglobal_load_lds_dwordx4 %0, off" :: "v"(gsrc), "s"(lds_dst_uniform) : "memory", "m0");
}
template <int NMAP, class AP, bool SWP = false>
DI void gemm_core_gg(unsigned char* smem, int K, const AP& ap, const bf16_t* wT, int ldk, int n0, f32x16 (&acc)[2][2]) {
  int tid_ = threadIdx.x;
  asm volatile("" : "+v"(tid_));
  const int tid = tid_, lane = tid & 63, wave = __builtin_amdgcn_readfirstlane(tid >> 6), wm = wave >> 1, wn = wave & 1, r32 = lane & 31, h = lane >> 5;
#pragma unroll
  for (int mi = 0; mi < 2; ++mi)
#pragma unroll
    for (int ni = 0; ni < 2; ++ni)
#pragma unroll
      for (int i = 0; i < 16; ++i) acc[mi][ni][i] = 0.f;
  const int grow = tid >> 2, gc = ((tid & 3) ^ ((tid >> 4) & 3)) * 8;
  const unsigned a0 = (ap.rowoff(grow) + gc) * 2u, a1 = (ap.rowoff(grow + 64) + gc) * 2u;
  const unsigned b0 = (unsigned)((n0 + grow) * ldk + gc) * 2u, b1 = b0 + (unsigned)(64 * ldk) * 2u;
  const bf16_t *sa, *sbw;
  { unsigned long long u = (unsigned long long)ap.base();
    u = ((unsigned long long)(unsigned)__builtin_amdgcn_readfirstlane((int)(u >> 32)) << 32) | (unsigned)__builtin_amdgcn_readfirstlane((int)u); sa = (const bf16_t*)u; }
  { unsigned long long u = (unsigned long long)wT;
    u = ((unsigned long long)(unsigned)__builtin_amdgcn_readfirstlane((int)(u >> 32)) << 32) | (unsigned)__builtin_amdgcn_readfirstlane((int)u); sbw = (const bf16_t*)u; }
  const unsigned wbase = __builtin_amdgcn_readfirstlane(lds_off(smem) + wave * 1024);
  glds16_s(a0, sa, wbase); glds16_s(a1, sa, wbase + 4096); glds16_s(b0, sbw, wbase + 8192); glds16_s(b1, sbw, wbase + 12288);
  glds16_s(a0, sa + 32, wbase + G_STAGE); glds16_s(a1, sa + 32, wbase + G_STAGE + 4096); glds16_s(b0, sbw + 32, wbase + G_STAGE + 8192); glds16_s(b1, sbw + 32, wbase + G_STAGE + 12288);
  { const bf16_t* ska = sa + 64; const bf16_t* skb = sbw + 64; const unsigned d2 = wbase + 2 * G_STAGE;
    glds16_s(a0, ska, d2); glds16_s(a1, ska, d2 + 4096); glds16_s(b0, skb, d2 + 8192); glds16_s(b1, skb, d2 + 12288); }
  int cur = 0;
  for (int k0 = 0; k0 < K; k0 += 32) {
    if (k0 == 0) asm volatile("s_waitcnt vmcnt(8)" ::: "memory");
    else if (k0 + 32 < K) asm volatile("s_waitcnt vmcnt(4)" ::: "memory");
    else asm volatile("s_waitcnt vmcnt(0)" ::: "memory");
    __builtin_amdgcn_s_barrier();
    asm volatile("" ::: "memory");
    if (k0 > 0 && k0 + 64 < K) {
      int nx = cur + 2; if (nx >= 3) nx -= 3;
      const unsigned d2 = wbase + nx * G_STAGE;
      const bf16_t* ska = sa + k0 + 64; const bf16_t* skb = sbw + k0 + 64;
      glds16_s(a0, ska, d2); glds16_s(a1, ska, d2 + 4096); glds16_s(b0, skb, d2 + 8192); glds16_s(b1, skb, d2 + 12288);
    }
    gemm_compute_g<NMAP, SWP>(smem + cur * G_STAGE, acc, wm, wn, r32, h);
    cur = (cur == 2) ? 0 : cur + 1;
  }
  __syncthreads();
}

template <int NMAP, class AP>
DI void gemm_core_gf(unsigned char* smem, int K, const AP& ap, const float* wa, const float* wb, int ldb, int ca, int cb, f32x16 (&acc)[2][2]) {
  const int tid = threadIdx.x, lane = tid & 63, wave = __builtin_amdgcn_readfirstlane(tid >> 6), wm = wave >> 1, wn = wave & 1, r32 = lane & 31, h = lane >> 5;
#pragma unroll
  for (int mi = 0; mi < 2; ++mi)
#pragma unroll
    for (int ni = 0; ni < 2; ++ni)
#pragma unroll
      for (int i = 0; i < 16; ++i) acc[mi][ni][i] = 0.f;
  const int grow = tid >> 2, gc = ((tid & 3) ^ ((tid >> 4) & 3)) * 8;
  const bf16_t* a0 = ap.rowptr(grow) + gc;
  const bf16_t* a1 = ap.rowptr(grow + 64) + gc;
  const int np = tid & 63, kk = tid >> 6;
  const float* bbase = ((np < 32) ? (wa + ca + 2 * np) : (wb + cb + 2 * (np - 32))) + (size_t)(8 * kk) * ldb;
  const int bo0 = swz_off(2 * np, kk), bo1 = swz_off(2 * np + 1, kk);
  unsigned char* dst = smem + tid * 16;
  float2 rb[8];
  auto bload = [&](int k0) {
#pragma unroll
    for (int j = 0; j < 8; ++j) rb[j] = *(const float2*)(bbase + (size_t)(k0 + j) * ldb);
  };
  auto bstore = [&](unsigned char* Bs) {
    float v0[8], v1[8];
#pragma unroll
    for (int j = 0; j < 8; ++j) { v0[j] = rb[j].x; v1[j] = rb[j].y; }
    bf16x8 hi, lo;
    cvt8<false>(v0, hi, lo); *(bf16x8*)(Bs + bo0) = hi;
    cvt8<false>(v1, hi, lo); *(bf16x8*)(Bs + bo1) = hi;
  };
  glds16(a0, dst); glds16(a1, dst + 4096);
  bload(0);
  bstore(smem + 8192);
  __syncthreads();
  int cur = 0;
  for (int k0 = 0; k0 < K; k0 += 32) {
    const bool more = k0 + 32 < K;
    if (more) {
      unsigned char* d2 = dst + (cur ^ 1) * G_STAGE;
      glds16(a0 + k0 + 32, d2); glds16(a1 + k0 + 32, d2 + 4096);
      bload(k0 + 32);
    }
    gemm_compute_g<NMAP>(smem + cur * G_STAGE, acc, wm, wn, r32, h);
    if (more) bstore(smem + (cur ^ 1) * G_STAGE + 8192);
    __syncthreads();
    cur ^= 1;
  }
}
#endif

struct AF_hl {
  struct Raw { u32x4 hv, lv; };
  const bf16_t* hi; const bf16_t* lo; int ld;
  DI void load(int row, int k, Raw& r) const { r.hv = *(const u32x4*)(hi + (size_t)row * ld + k); r.lv = *(const u32x4*)(lo + (size_t)row * ld + k); }
  DI void cvt(const Raw& r, int, int, bf16x8& h, bf16x8& l) const { h = __builtin_bit_cast(bf16x8, r.hv); l = __builtin_bit_cast(bf16x8, r.lv); }
};


#if !ORACLE
template <int CPR, class RowPtr, bool NT = false>
DI void epi_flush_bf16(const bf16_t* T, int ld, int rows, RowPtr rp) {
  const int total = rows * CPR;
  for (int c = threadIdx.x; c < total; c += NTHREADS) {
    const int row = c / CPR, cc = (c % CPR) * 8;
    bf16_t* d = rp(row);
    if (d) {
      const u32x4 v = *(const u32x4*)&T[row * ld + cc];
      if (NT) __builtin_nontemporal_store(v, (u32x4*)(d + cc));
      else *(u32x4*)(d + cc) = v;
    }
  }
}
#endif

DI void prep_tile(unsigned char* smem, const float* src, int ld_src, bf16_t* dhi, bf16_t* dlo, int K, int kt, int nt, int mode, int nsrc) {
  if (mode == 1) K = LDH;
  float* T = (float*)smem;
  const int tid = threadIdx.x;
  __syncthreads();
  {
    const int kk = tid >> 4, n4 = (tid & 15) * 4;
#pragma unroll
    for (int i = 0; i < 4; ++i) {
      const int k = kt * 64 + kk + 16 * i;
      float v[4];
#pragma unroll
      for (int e = 0; e < 4; ++e) {
        const int nd = nt * 64 + n4 + e;
        int ns = nd;
        if (mode == 1) ns = (nd >= 920 && nd < 960) ? -1 : (nd < 920 ? nd : nd - 40);
        v[e] = (ns >= 0 && ns < nsrc) ? src[(size_t)k * ld_src + ns] : 0.f;
      }
#pragma unroll
      for (int e = 0; e < 4; ++e) T[(n4 + e) * 65 + kk + 16 * i] = v[e];
    }
  }
  __syncthreads();
  {
    const int n = tid >> 2, kc = (tid & 3) * 16;
    float v[8];
    bf16x8 hi, lo;
#pragma unroll
    for (int half = 0; half < 2; ++half) {
#pragma unroll
      for (int j = 0; j < 8; ++j) v[j] = T[n * 65 + kc + half * 8 + j];
      cvt8<true>(v, hi, lo);
      const size_t o = (size_t)(nt * 64 + n) * K + kt * 64 + kc + half * 8;
      *(bf16x8*)(dhi + o) = hi;
      *(bf16x8*)(dlo + o) = lo;
    }
  }
}

template <int PART>
DI void phase0(const Params& p, unsigned char* smem) {
  const int tid = threadIdx.x;
  if (PART == 0 && blockIdx.x == 0) {
    for (int i = tid; i < NEXP + 1; i += NTHREADS) p.cnt[i * CNT_STRIDE] = 0;
    if (tid < 8) p.ctr[tid] = 0;
  }
  constexpr int T_MOD = 192, T_ROPE = 512;
  constexpr int T_WIN = 16 * 40, T_WOUT = 16 * 16, T_WR = 16 * 4, T_W1 = 32 * 4, T_W2 = 4;
  constexpr int E0 = T_MOD + T_ROPE, E1 = E0 + T_WIN, E2 = E1 + T_WOUT, E3 = E2 + T_WR, E4 = E3 + T_W1, E5 = E4 + T_W1, E6 = E5 + T_W2, E7 = E6 + T_W2;
  for (int tile = (PART == 0 ? 0 : E0) + blockIdx.x; tile < (PART == 0 ? E0 : E7); tile += gridDim.x) {
    if (tile < T_MOD) {
      float* cond = (float*)smem;
      float* red = cond + 8 * 1024;
      __syncthreads();
      {
        float4 cv[8];
#pragma unroll
        for (int q = 0; q < 8; ++q) cv[q] = *(const float4*)(p.c + (q * NTHREADS + tid) * 4);
#pragma unroll
        for (int q = 0; q < 8; ++q) {
          const int i = (q * NTHREADS + tid) * 4;
          cond[i] = siluf_(cv[q].x); cond[i + 1] = siluf_(cv[q].y); cond[i + 2] = siluf_(cv[q].z); cond[i + 3] = siluf_(cv[q].w);
        }
      }
      __syncthreads();
      const int col = tid & 31, kp = tid >> 5, j0 = tile * 32;
      float a[8];
#pragma unroll
      for (int b = 0; b < 8; ++b) a[b] = 0.f;
      for (int k0 = kp * 128; k0 < kp * 128 + 128; k0 += 16) {
        float w[16];
#pragma unroll
        for (int u = 0; u < 16; ++u) w[u] = p.w_ada[(size_t)(k0 + u) * 6144 + j0 + col];
#pragma unroll
        for (int u = 0; u < 16; ++u)
#pragma unroll
          for (int b = 0; b < 8; ++b) a[b] += cond[b * 1024 + k0 + u] * w[u];
      }
#pragma unroll
      for (int b = 0; b < 8; ++b) red[(kp * 8 + b) * 32 + col] = a[b];
      __syncthreads();
      {
        const int b = tid >> 5;
        float sacc = 0.f;
#pragma unroll
        for (int q = 0; q < 8; ++q) sacc += red[(q * 8 + b) * 32 + col];
        p.mod[b * 6144 + j0 + col] = sacc + p.b_ada[j0 + col];
      }
    } else if (tile < E0) {
      const int idx = (tile - T_MOD) * 256 + tid;
      const int pos = idx >> 5, i = idx & 31;
      const float inv = (float)pow(10000.0, -(double)(2 * i) / 64.0);
      const float ang = (float)pos * inv;
      *(float2*)(p.ropec + 2 * idx) = make_float2((float)cos((double)ang), (float)sin((double)ang));
    } else if (tile < E1) { const int t = tile - E0; prep_tile(smem, p.w_in, INC, p.winT, p.winTl, 1024, t / 40, t % 40, 1, INC); }
    else if (tile < E2) { const int t = tile - E1; prep_tile(smem, p.w_out, 1024, p.woutT, p.woutTl, 1024, t >> 4, t & 15, 0, 1024); }
    else if (tile < E3) { const int t = tile - E2; prep_tile(smem, p.w_router, 256, p.wrT, p.wrTl, 1024, t >> 2, t & 3, 0, 256); }
    else if (tile < E4) { const int t = tile - E3; prep_tile(smem, p.w1_k, 256, p.w1kT, p.w1kTl, 2048, t >> 2, t & 3, 0, 256); }
    else if (tile < E5) { const int t = tile - E4; prep_tile(smem, p.w1_v, 256, p.w1vT, p.w1vTl, 2048, t >> 2, t & 3, 0, 256); }
    else if (tile < E6) { const int t = tile - E5; prep_tile(smem, p.w2_k, 64, p.w2kT, p.w2kTl, 256, t, 0, 0, 64); }
    else { const int t = tile - E6; prep_tile(smem, p.w2_v, 64, p.w2vT, p.w2vTl, 256, t, 0, 0, 64); }
  }
}

#if ORACLE
DI void phase0b(const Params& p) {
  const int tid = otid(), lane = tid & 63, wave = __builtin_amdgcn_readfirstlane(tid >> 6);
  const int gw = blockIdx.x * 4 + wave, nw = gridDim.x * 4;
  for (int tok = gw; tok < NT; tok += nw) {
    const int b = tok >> 12;
    const float* xr = p.x + (size_t)tok * DM;
    float4 xv[4];
    float ss = 0.f;
#pragma unroll
    for (int j = 0; j < 4; ++j) {
      xv[j] = *(const float4*)(xr + lane * 4 + 256 * j);
      ss += xv[j].x * xv[j].x + xv[j].y * xv[j].y + xv[j].z * xv[j].z + xv[j].w * xv[j].w;
    }
    ss = wave_sum(ss);
    const float rsv = 1.0f / sqrtf(ss * (1.0f / DM) + 1e-6f);
    act_t* hr = p.h1 + (size_t)tok * LDH;
#pragma unroll
    for (int j = 0; j < 4; ++j) {
      const int c = lane * 4 + 256 * j;
      const float4 g = *(const float4*)(p.g_attn + c);
      const float4 sc = *(const float4*)(p.mod + b * 6144 + 1024 + c);
      const float4 sh = *(const float4*)(p.mod + b * 6144 + c);
      st4(hr + c, xv[j].x * rsv * (g.x * (1.0f + sc.x)) + sh.x, xv[j].y * rsv * (g.y * (1.0f + sc.y)) + sh.y,
          xv[j].z * rsv * (g.z * (1.0f + sc.z)) + sh.z, xv[j].w * rsv * (g.w * (1.0f + sc.w)) + sh.w);
    }
  }
}
#else
DI void phase0b(const Params& p) {
  const int tid = otid(), lane = tid & 63, wave = __builtin_amdgcn_readfirstlane(tid >> 6);
  const int gw = blockIdx.x * 4 + wave, nw = gridDim.x * 4;
  for (int tok = gw; tok < NT; tok += nw) {
    const int b = tok >> 12;
    const float* xr = p.x + (size_t)tok * DM;
    float xv[16];
    float ss = 0.f;
#pragma unroll
    for (int j = 0; j < 2; ++j) {
      const float4 a0 = *(const float4*)(xr + lane * 8 + 512 * j), a1 = *(const float4*)(xr + lane * 8 + 512 * j + 4);
      float* xx = xv + 8 * j;
      xx[0] = a0.x; xx[1] = a0.y; xx[2] = a0.z; xx[3] = a0.w; xx[4] = a1.x; xx[5] = a1.y; xx[6] = a1.z; xx[7] = a1.w;
#pragma unroll
      for (int q = 0; q < 8; ++q) ss += xx[q] * xx[q];
    }
    ss = wave_sum(ss);
    const float rsv = 1.0f / sqrtf(ss * (1.0f / DM) + 1e-6f);
    act_t* hr = p.h1 + (size_t)tok * LDH;
#pragma unroll
    for (int j = 0; j < 2; ++j) {
      const int c = lane * 8 + 512 * j;
      float o[8];
#pragma unroll
      for (int hh = 0; hh < 2; ++hh) {
        const float4 g = *(const float4*)(p.g_attn + c + 4 * hh);
        const float4 sc = *(const float4*)(p.mod + b * 6144 + 1024 + c + 4 * hh);
        const float4 sh = *(const float4*)(p.mod + b * 6144 + c + 4 * hh);
        const float* xx = xv + 8 * j + 4 * hh;
        o[4 * hh] = xx[0] * rsv * (g.x * (1.0f + sc.x)) + sh.x; o[4 * hh + 1] = xx[1] * rsv * (g.y * (1.0f + sc.y)) + sh.y;
        o[4 * hh + 2] = xx[2] * rsv * (g.z * (1.0f + sc.z)) + sh.z; o[4 * hh + 3] = xx[3] * rsv * (g.w * (1.0f + sc.w)) + sh.w;
      }
      st8bf(hr + c, o);
    }
  }
}
#endif

template <class T> struct AF_rows {
  typedef typename RawOf<T>::type Raw;
  const T* src; int ld;
  DI void load(int row, int k, Raw& r) const { raw_load(src + (size_t)row * ld + k, r); }
  DI void cvt(const Raw& r, int row, int k, bf16x8& hi, bf16x8& lo) const { raw_frag<kSplit>(r, hi, lo); }
};

DI void phase1(const Params& p, unsigned char* smem) {
  const int tid = threadIdx.x, lane = tid & 63, wave = __builtin_amdgcn_readfirstlane(tid >> 6), wm = wave >> 1, wn = wave & 1, r32 = lane & 31, h = lane >> 5;
  const int vbid = (blockIdx.x & 7) * (gridDim.x >> 3) + (blockIdx.x >> 3);
  for (int tile = vbid; tile < 256 * 20; tile += gridDim.x) {
    const int grp = tile / 1280, tg = tile % 1280;
    const int mt = tg / 5, nt = grp * 5 + tg % 5;
    const int b = mt >> 5, t0 = mt * 128;
    AF_rows<act_t> af; af.src = p.h1 + (size_t)t0 * LDH; af.ld = LDH;
    BT16 bp; bp.w = p.winT; bp.wlo = p.winTl; bp.ldk = LDH; bp.n0 = nt * 128;
    f32x16 acc[2][2];
#if ORACLE
    gemm_core<kSplit, 0, AF_rows<act_t>, BT16, false>(smem, DM, af, bp, acc);
#else
    { AP_rows ap; ap.src = af.src; ap.ld = LDH; gemm_core_gg<0>(smem, DM, ap, p.winT, LDH, nt * 128, acc); }
#endif
    const int eslot = nt * 2 + wn;
#if ORACLE
    if (eslot >= 39) continue;
    const bool is_q = (eslot < 8) || (eslot >= SLOT_MQ && eslot < SLOT_MQ + 8);
    const bool is_rope = is_q || eslot == SLOT_KCMP || eslot == SLOT_KSLC || eslot == SLOT_KWIN || (eslot >= SLOT_MK && eslot < SLOT_MK + 8);
    const bool is_vt = eslot == SLOT_VSLC || eslot == SLOT_VWIN || eslot >= SLOT_MV;
    const int posb = (mt & 31) * 128;
    if (is_vt) {
      const int vidx = (eslot == SLOT_VSLC) ? b : ((eslot == SLOT_VWIN) ? 8 + b : 16 + b * 8 + (eslot - SLOT_MV));
      act_t* vb = p.vT_slc + (size_t)vidx * 64 * SEQ;
#pragma unroll
      for (int mi = 0; mi < 2; ++mi)
#pragma unroll
        for (int ni = 0; ni < 2; ++ni)
#pragma unroll
          for (int g = 0; g < 4; ++g) {
            const int pos = posb + wm * 64 + mi * 32 + 8 * g + 4 * h;
            const int d = ni * 32 + r32;
            st4(vb + (size_t)d * SEQ + pos, acc[mi][ni][4 * g], acc[mi][ni][4 * g + 1], acc[mi][ni][4 * g + 2], acc[mi][ni][4 * g + 3]);
          }
    } else {
#pragma unroll
      for (int mi = 0; mi < 2; ++mi)
#pragma unroll
        for (int i = 0; i < 16; ++i) {
          const int tl = wm * 64 + mi * 32 + crow(i, h);
          const int pos = posb + tl;
          float t1 = acc[mi][0][i], t2 = acc[mi][1][i];
          act_t* dst = p.proj + (size_t)(t0 + tl) * NP + eslot * 64 + r32;
          if (is_rope) {
            const float2 csn = *(const float2*)(p.ropec + 2 * (pos * 32 + r32));
            const float cs = csn.x, sn = csn.y;
            float o1 = t1 * cs - t2 * sn, o2 = t2 * cs + t1 * sn;
            if (is_q) { o1 *= QSCALE; o2 *= QSCALE; }
            st1(dst, o1); st1(dst + 32, o2);
          } else if (eslot == SLOT_GATE) {
            if (r32 < 24) st1(dst, sigmoidf_(t1));
          } else {
            st1(dst, t1); st1(dst + 32, t2);
          }
        }
    }
#else
    {
      const bool is_q = (eslot < 8) || (eslot >= SLOT_MQ && eslot < SLOT_MQ + 8);
      const bool is_rope = is_q || eslot == SLOT_KCMP || eslot == SLOT_KSLC || eslot == SLOT_KWIN || (eslot >= SLOT_MK && eslot < SLOT_MK + 8);
      const bool is_vt = eslot == SLOT_VSLC || eslot == SLOT_VWIN || (eslot >= SLOT_MV && eslot < 39);
      const int posb = (mt & 31) * 128;
      bf16_t* T = (bf16_t*)smem + wn * (128 * 72);
      if (eslot < 39) {
        if (is_vt) {
#pragma unroll
          for (int mi = 0; mi < 2; ++mi)
#pragma unroll
            for (int ni = 0; ni < 2; ++ni)
#pragma unroll
              for (int g = 0; g < 4; ++g) {
                uint2 u;
                u.x = pack2bf(acc[mi][ni][4 * g], acc[mi][ni][4 * g + 1]);
                u.y = pack2bf(acc[mi][ni][4 * g + 2], acc[mi][ni][4 * g + 3]);
                *(uint2*)&T[(ni * 32 + r32) * 136 + wm * 64 + mi * 32 + 8 * g + 4 * h] = u;
              }
        } else {
          if (is_rope) {
            const float qs = is_q ? QSCALE : 1.0f;
#pragma unroll
            for (int mi = 0; mi < 2; ++mi) {
              float2 csn[16];
#pragma unroll
              for (int i = 0; i < 16; ++i) csn[i] = *(const float2*)(p.ropec + 2 * ((posb + wm * 64 + mi * 32 + crow(i, h)) * 32 + r32));
#pragma unroll
              for (int i = 0; i < 16; ++i) {
                const int tl = wm * 64 + mi * 32 + crow(i, h);
                const float t1 = acc[mi][0][i], t2 = acc[mi][1][i];
                float o1 = t1 * csn[i].x - t2 * csn[i].y, o2 = t2 * csn[i].x + t1 * csn[i].y;
                if (is_q) { o1 *= QSCALE; o2 *= QSCALE; }
                T[tl * 72 + r32] = f2bf(o1);
                T[tl * 72 + 32 + r32] = f2bf(o2);
              }
            }
            (void)qs;
          } else if (eslot == SLOT_GATE) {
#pragma unroll
            for (int mi = 0; mi < 2; ++mi)
#pragma unroll
              for (int i = 0; i < 16; ++i) {
                const int tl = wm * 64 + mi * 32 + crow(i, h);
                T[tl * 72 + r32] = f2bf(sigmoidf_fast(acc[mi][0][i]));
                T[tl * 72 + 32 + r32] = f2bf(acc[mi][1][i]);
              }
          } else {
#pragma unroll
            for (int mi = 0; mi < 2; ++mi)
#pragma unroll
              for (int i = 0; i < 16; ++i) {
                const int tl = wm * 64 + mi * 32 + crow(i, h);
                T[tl * 72 + r32] = f2bf(acc[mi][0][i]);
                T[tl * 72 + 32 + r32] = f2bf(acc[mi][1][i]);
              }
          }
        }
      }
      __syncthreads();
#pragma unroll 1
      for (int half = 0; half < 2; ++half) {
        const int sl = nt * 2 + half;
        if (sl >= 39) break;
        const bf16_t* Th = (const bf16_t*)smem + half * (128 * 72);
        const bool vt = sl == SLOT_VSLC || sl == SLOT_VWIN || sl >= SLOT_MV;
        if (vt) {
          const int vidx = (sl == SLOT_VSLC) ? b : ((sl == SLOT_VWIN) ? 8 + b : 16 + b * 8 + (sl - SLOT_MV));
          bf16_t* vb = p.vT_slc + (size_t)vidx * 64 * SEQ + posb;
          { auto rp = [&](int d) { return vb + (size_t)d * SEQ; }; epi_flush_bf16<16, decltype(rp), true>(Th, 136, 64, rp); }
        } else {
          bf16_t* pb = p.proj + (size_t)t0 * NP + sl * 64;
          { auto rp = [&](int r) { return pb + (size_t)r * NP; }; epi_flush_bf16<8, decltype(rp), true>(Th, 72, 128, rp); }
        }
      }
      __syncthreads();
    }
#endif
  }
}

struct AF_cmp {
  typedef typename RawOf<act_t>::type Raw;
  const act_t* proj; const float* pos; int r0; int col; int l0;
  DI void load(int row, int k, Raw& r) const {
    const int rr = r0 + row, b = rr >> 8, n = rr & 255, l = l0 + (k >> 6), d = k & 63;
    raw_load(proj + (size_t)(b * SEQ + 16 * n + l) * NP + col + d, r);
  }
  DI void cvt(const Raw& r, int row, int k, bf16x8& hi, bf16x8& lo) const {
    float v[8];
    raw_floats(r, v);
#pragma unroll
    for (int j = 0; j < 8; ++j) v[j] += pos[k + j];
    cvt8<kSplit>(v, hi, lo);
  }
};

DI void phase2a(const Params& p, unsigned char* smem) {
  const int tid = threadIdx.x, lane = tid & 63, wave = __builtin_amdgcn_readfirstlane(tid >> 6), wm = wave >> 1, wn = wave & 1, r32 = lane & 31, h = lane >> 5;
  for (int tile = blockIdx.x; tile < 256 + 128; tile += gridDim.x) {
    if (tile < 256) {
      const int ks = tile >> 6, which = (tile >> 5) & 1, mt = (tile >> 1) & 15, nt = tile & 1;
      AF_cmp af; af.proj = p.proj; af.pos = (which ? p.pos_v : p.pos_k) + ks * 512; af.r0 = mt * 128; af.col = (which ? SLOT_VCMP : SLOT_KCMP) * 64; af.l0 = ks * 8;
      BT16 bp; bp.w = (which ? p.w1vT : p.w1kT) + ks * 512; bp.wlo = (which ? p.w1vTl : p.w1kTl) + ks * 512; bp.ldk = 2048; bp.n0 = nt * 128;
      f32x16 acc[2][2];
      gemm_core<kSplit, 0>(smem, 512, af, bp, acc);
      float* hb = p.hidp + (size_t)(ks * 2 + which) * 2048 * 256;
#pragma unroll
      for (int mi = 0; mi < 2; ++mi)
#pragma unroll
        for (int ni = 0; ni < 2; ++ni)
#pragma unroll
          for (int i = 0; i < 16; ++i) {
            const int r = mt * 128 + wm * 64 + mi * 32 + crow(i, h);
            const int cc = nt * 128 + wn * 64 + ni * 32 + r32;
            hb[(size_t)r * 256 + cc] = acc[mi][ni][i];
          }
    } else {
      const int it = tile - 256, b = it >> 4, blk = it & 15;
      const int cg = tid & 63, tq = tid >> 6;
      const act_t* src = p.proj + (size_t)(b * SEQ + blk * 256 + tq * 64) * NP + SLOT_MK * 64 + 8 * cg;
      float sum[8];
#pragma unroll
      for (int j = 0; j < 8; ++j) sum[j] = 0.f;
#pragma unroll 8
      for (int t = 0; t < 64; ++t) {
        typename RawOf<act_t>::type r;
        raw_load(src + (size_t)t * NP, r);
        float v[8];
        raw_floats(r, v);
#pragma unroll
        for (int j = 0; j < 8; ++j) sum[j] += v[j];
      }
      float* red = (float*)smem;
      __syncthreads();
#pragma unroll
      for (int j = 0; j < 8; ++j) red[tq * 512 + 8 * cg + j] = sum[j];
      __syncthreads();
      {
        const int c0 = 2 * tid, hd = c0 >> 6, d = c0 & 63;
        float* dst = p.kmean + (size_t)((b * 8 + hd) * 16 + blk) * 64 + d;
        dst[0] = (red[c0] + red[512 + c0] + red[1024 + c0] + red[1536 + c0]) * (1.0f / 256.0f);
        dst[1] = (red[c0 + 1] + red[512 + c0 + 1] + red[1024 + c0 + 1] + red[1536 + c0 + 1]) * (1.0f / 256.0f);
      }
    }
  }
}

struct AF_hidsum {
  struct Raw { float4 v[8]; };
  const float* src;
  DI void load(int row, int k, Raw& r) const {
#pragma unroll
    for (int ks = 0; ks < 4; ++ks) {
      const float* q = src + (size_t)ks * 2 * 2048 * 256 + (size_t)row * 256 + k;
      r.v[2 * ks] = *(const float4*)q; r.v[2 * ks + 1] = *(const float4*)(q + 4);
    }
  }
  DI void cvt(const Raw& r, int, int, bf16x8& hi, bf16x8& lo) const {
    float v[8];
    v[0] = r.v[0].x + r.v[2].x + r.v[4].x + r.v[6].x; v[1] = r.v[0].y + r.v[2].y + r.v[4].y + r.v[6].y;
    v[2] = r.v[0].z + r.v[2].z + r.v[4].z + r.v[6].z; v[3] = r.v[0].w + r.v[2].w + r.v[4].w + r.v[6].w;
    v[4] = r.v[1].x + r.v[3].x + r.v[5].x + r.v[7].x; v[5] = r.v[1].y + r.v[3].y + r.v[5].y + r.v[7].y;
    v[6] = r.v[1].z + r.v[3].z + r.v[5].z + r.v[7].z; v[7] = r.v[1].w + r.v[3].w + r.v[5].w + r.v[7].w;
#pragma unroll
    for (int j = 0; j < 8; ++j) v[j] = siluf_(v[j]);
    cvt8<kSplit>(v, hi, lo);
  }
};

DI void phase2b(const Params& p, unsigned char* smem) {
  const int tid = threadIdx.x, lane = tid & 63, wave = __builtin_amdgcn_readfirstlane(tid >> 6), wm = wave >> 1, wn = wave & 1, r32 = lane & 31, h = lane >> 5;
  for (int tile = blockIdx.x; tile < 32; tile += gridDim.x) {
    const int which = tile >> 4, mt = tile & 15;
    AF_hidsum af; af.src = p.hidp + (size_t)which * 2048 * 256 + (size_t)mt * 128 * 256;
    BT16 bp; bp.w = which ? p.w2vT : p.w2kT; bp.wlo = which ? p.w2vTl : p.w2kTl; bp.ldk = 256; bp.n0 = 0;
    f32x16 acc[2][2];
    gemm_core<kSplit, 0>(smem, 256, af, bp, acc);
    if (wn != 0) continue;
    if (which == 0) {
#pragma unroll
      for (int mi = 0; mi < 2; ++mi)
#pragma unroll
        for (int ni = 0; ni < 2; ++ni)
#pragma unroll
          for (int i = 0; i < 16; ++i) {
            const int r = mt * 128 + wm * 64 + mi * 32 + crow(i, h);
            st1(p.kc + (size_t)r * 64 + ni * 32 + r32, acc[mi][ni][i]);
          }
    } else {
#pragma unroll
      for (int mi = 0; mi < 2; ++mi)
#pragma unroll
        for (int ni = 0; ni < 2; ++ni)
#pragma unroll
          for (int g = 0; g < 4; ++g) {
            const int r = mt * 128 + wm * 64 + mi * 32 + 8 * g + 4 * h;
            const int b = r >> 8, n = r & 255, d = ni * 32 + r32;
            st4(p.vcT + (size_t)(b * 64 + d) * 256 + n, acc[mi][ni][4 * g], acc[mi][ni][4 * g + 1], acc[mi][ni][4 * g + 2], acc[mi][ni][4 * g + 3]);
          }
    }
  }
}

constexpr int KS_LD = 72, VS_LD = 68;
constexpr int KS_BYTES = 64 * KS_LD * 2, VS_BYTES = 64 * VS_LD * 2;
struct FlashSt { f32x16 o[2][2]; float m[2]; float l[2]; };
struct AttnLds { bf16_t *Ks, *Vs, *Qs; };
constexpr int QS_BYTES = 4 * 2 * 4 * 64 * 16;

DI void flash_init(FlashSt& st) {
#pragma unroll
  for (int qi = 0; qi < 2; ++qi) {
    st.m[qi] = -1e30f; st.l[qi] = 0.f;
#pragma unroll
    for (int dt = 0; dt < 2; ++dt)
#pragma unroll
      for (int i = 0; i < 16; ++i) st.o[qi][dt][i] = 0.f;
  }
}

DI void qk_tile(const AttnLds& L, f32x16 (&s)[2][2], int lane) {
  const int r32 = lane & 31, h = lane >> 5;
#pragma unroll
  for (int kt = 0; kt < 2; ++kt)
#pragma unroll
    for (int qi = 0; qi < 2; ++qi)
#pragma unroll
      for (int i = 0; i < 16; ++i) s[kt][qi][i] = 0.f;
#pragma unroll
  for (int kt = 0; kt < 2; ++kt)
#pragma unroll
    for (int ks = 0; ks < 4; ++ks) {
      const int off = (kt * 32 + r32) * KS_LD + ks * 16 + h * 8;
      const bf16x8 a = *(const bf16x8*)&L.Ks[off];
#pragma unroll
      for (int qi = 0; qi < 2; ++qi) {
        const bf16x8 qv = *(const bf16x8*)&L.Qs[((qi * 4 + ks) * 64 + lane) * 8];
        s[kt][qi] = MFMA(a, qv, s[kt][qi]);
      }
    }
}

constexpr float LZ_HI = 8.0f, LZ_LO = -64.0f;
template <int QI, class MaskF>
DI void flash_half(const AttnLds& L, FlashSt& st, int mode, const MaskF& mf, int lane) {
  const int r32 = lane & 31, h = lane >> 5;
  const float mref = st.m[QI];
  const bool fresh = mref < -1e29f;
  const float base = fresh ? 0.f : mref;
  float cinit = -base;
  if (mode == 1) cinit = mf.live(QI) ? cinit : -INFINITY;
  f32x16 s[2];
#pragma unroll
  for (int kt = 0; kt < 2; ++kt)
#pragma unroll
    for (int i = 0; i < 16; ++i) s[kt][i] = cinit;
#pragma unroll
  for (int ks = 0; ks < 4; ++ks) {
    const bf16x8 qv = *(const bf16x8*)&L.Qs[((QI * 4 + ks) * 64 + lane) * 8];
#pragma unroll
    for (int kt = 0; kt < 2; ++kt) {
      const bf16x8 a = *(const bf16x8*)&L.Ks[(kt * 32 + r32) * KS_LD + ks * 16 + h * 8];
      s[kt] = MFMA(a, qv, s[kt]);
    }
  }
  if (mode == 2) {
    int kofs = 4 * h;
    asm volatile("; per-element mask" : "+v"(kofs) :: "memory");
    const int klo = mf.lo(QI), khi = mf.hi(QI);
    const bool kempty = khi < klo;
    const int lo2 = (kempty ? 0x100000 : klo) - kofs;
    const unsigned span = kempty ? 0u : (unsigned)(khi - klo);
#pragma unroll
    for (int kt = 0; kt < 2; ++kt)
#pragma unroll
      for (int i = 0; i < 16; ++i)
        if ((unsigned)(kt * 32 + crow(i, 0) - lo2) > span) s[kt][i] = -INFINITY;
  }
  float mx = -INFINITY;
#pragma unroll
  for (int kt = 0; kt < 2; ++kt)
#pragma unroll
    for (int i = 0; i < 16; ++i) mx = fmaxf(mx, s[kt][i]);
  mx = pair_max32(mx);
  const bool anyvis = mx > -INFINITY;
  const bool need = (mx > LZ_HI) | (fresh & anyvis & (mx < LZ_LO));
  const float keep = (fresh & !anyvis) ? mref : base;
  st.m[QI] = need ? base + mx : keep;
  if (__builtin_amdgcn_ballot_w64(need) != 0ull) {
    asm volatile("; rescale path" ::: "memory");
    const float delta = need ? mx : 0.f;
    const float alpha = __builtin_amdgcn_exp2f(-fmaxf(delta, 0.f));
    st.l[QI] *= alpha;
#pragma unroll
    for (int dt = 0; dt < 2; ++dt)
#pragma unroll
      for (int i = 0; i < 16; ++i) st.o[QI][dt][i] *= alpha;
#pragma unroll
    for (int kt = 0; kt < 2; ++kt)
#pragma unroll
      for (int i = 0; i < 16; ++i) s[kt][i] -= delta;
  }
  float sum = 0.f;
#pragma unroll
  for (int kt = 0; kt < 2; ++kt)
#pragma unroll
    for (int i = 0; i < 16; ++i) {
      const float pv = __builtin_amdgcn_exp2f(s[kt][i]);
      s[kt][i] = pv;
      sum += pv;
    }
  st.l[QI] += sum;
#pragma unroll
  for (int kt = 0; kt < 2; ++kt)
#pragma unroll
    for (int s2 = 0; s2 < 2; ++s2) {
      bf16x8 ph;
#pragma unroll
      for (int j = 0; j < 8; ++j) ph[j] = (short)f2bf(s[kt][8 * s2 + j]);
#pragma unroll
      for (int dt = 0; dt < 2; ++dt) {
        const int off = (dt * 32 + r32) * VS_LD + kt * 32 + s2 * 16 + 4 * h;
        const s16x4 a0 = *(const s16x4*)&L.Vs[off];
        const s16x4 a1 = *(const s16x4*)&L.Vs[off + 8];
        const bf16x8 vh = __builtin_shufflevector(a0, a1, 0, 1, 2, 3, 4, 5, 6, 7);
        st.o[QI][dt] = MFMA(vh, ph, st.o[QI][dt]);
      }
    }
}
template <class MaskF>
DI void flash_tile(const AttnLds& L, FlashSt& st, int mode, const MaskF& mf, int lane) {
  flash_half<0>(L, st, mode, mf, lane);
  flash_half<1>(L, st, mode, mf, lane);
}

typedef typename RawOf<act_t>::type RawA;
DI void stage_k_load(const act_t* kb, size_t kstride, int tid, RawA (&rk)[2]) {
  const int row = tid >> 3, dc = (tid & 7) * 8;
  raw_load(kb + (size_t)row * kstride + dc, rk[0]);
  raw_load(kb + (size_t)(row + 32) * kstride + dc, rk[1]);
}
DI void stage_v_load(const act_t* vb, size_t vstride, int tid, RawA (&rv)[2]) {
  const int row = tid >> 3, kc = (tid & 7) * 8;
  raw_load(vb + (size_t)row * vstride + kc, rv[0]);
  raw_load(vb + (size_t)(row + 32) * vstride + kc, rv[1]);
}
DI void stage_k_store(const AttnLds& L, int tid, const RawA (&rk)[2]) {
  const int row = tid >> 3, dc = (tid & 7) * 8;
#pragma unroll
  for (int i = 0; i < 2; ++i) {
    bf16x8 hi, lo;
    raw_frag<false>(rk[i], hi, lo);
    *(bf16x8*)&L.Ks[(row + 32 * i) * KS_LD + dc] = hi;
  }
}
DI void stage_v_store(const AttnLds& L, int tid, const RawA (&rv)[2]) {
  const int row = tid >> 3, kc = (tid & 7) * 8;
#pragma unroll
  for (int i = 0; i < 2; ++i) {
    bf16x8 hi, lo;
    raw_frag<false>(rv[i], hi, lo);
    const int off = (row + 32 * i) * VS_LD + kc;
    *(s16x4*)&L.Vs[off] = __builtin_shufflevector(hi, hi, 0, 1, 2, 3);
    *(s16x4*)&L.Vs[off + 4] = __builtin_shufflevector(hi, hi, 4, 5, 6, 7);
  }
}

constexpr int KV2_OFF = 60416;
template <class MaskGen>
DI void run_branch(const AttnLds& L, const act_t* kbase, size_t kstride, const act_t* vbase, size_t vstride, int j0, int j1,
                   MaskGen& mg, FlashSt& st, int tid) {
  const int lane = tid & 63;
  if (j0 >= j1) return;
  RawA rk[2], rv[2];
  stage_k_load(kbase + (size_t)j0 * 64 * kstride, kstride, tid, rk);
  stage_v_load(vbase + (size_t)j0 * 64, vstride, tid, rv);
  __syncthreads();
  stage_k_store(L, tid, rk);
  stage_v_store(L, tid, rv);
  if (j0 + 1 < j1) {
    stage_k_load(kbase + (size_t)(j0 + 1) * 64 * kstride, kstride, tid, rk);
    stage_v_load(vbase + (size_t)(j0 + 1) * 64, vstride, tid, rv);
  }
  __syncthreads();
  int cur = 0;
  for (int j = j0; j < j1; ++j) {
    AttnLds Lc = L, Ln = L;
    Lc.Ks = L.Ks + cur * (KV2_OFF / 2); Lc.Vs = L.Vs + cur * (KV2_OFF / 2);
    Ln.Ks = L.Ks + (cur ^ 1) * (KV2_OFF / 2); Ln.Vs = L.Vs + (cur ^ 1) * (KV2_OFF / 2);
    if (!mg.skip(j)) {
      mg.set(j);
      const int md = __builtin_amdgcn_readfirstlane(mg.mode(j));
      flash_tile(Lc, st, md, mg, lane);
    }
    if (j + 1 < j1) {
      stage_k_store(Ln, tid, rk);
      stage_v_store(Ln, tid, rv);
      if (j + 2 < j1) {
        stage_k_load(kbase + (size_t)(j + 2) * 64 * kstride, kstride, tid, rk);
        stage_v_load(vbase + (size_t)(j + 2) * 64, vstride, tid, rv);
      }
    }
    __syncthreads();
    cur ^= 1;
  }
}

struct CmpMask {
  int t; int t0; int jj;
  DI bool skip(int) const { return false; }
  DI void set(int j) { jj = j; }
  DI int mode(int j) const { return (16 * (64 * j + 63) + 31 > t0) ? 2 : 0; }
  DI bool live(int) const { return true; }
  DI bool vis(int, int key) const { return 16 * (64 * jj + key) + 31 <= t; }
  DI int lo(int) const { return 0; }
  DI int hi(int) const { return ((t - 31) >> 4) - 64 * jj; }
};
struct SlcMask {
  unsigned long long msk; int cur; int t; int jj; bool sel;
  DI bool skip(int) const { return false; }
  DI void set(int j) { jj = j; sel = (msk >> j) & 1ull; }
  DI int mode(int j) const { return (j == cur) ? 2 : (__all(sel) ? 0 : 1); }
  DI bool live(int) const { return sel; }
  DI bool vis(int, int key) const { return sel && (64 * jj + key <= t); }
  DI int lo(int) const { return 0; }
  DI int hi(int) const { return sel ? t - 64 * jj : -1; }
};
struct WinMask {
  int t; int t0; int jj;
  DI bool skip(int) const { return false; }
  DI void set(int j) { jj = j; }
  DI int mode(int j) const { return ((64 * j + 63 > t0) || (64 * j <= t0 + 31 - 512)) ? 2 : 0; }
  DI bool live(int) const { return true; }
  DI bool vis(int, int key) const { const int kp = 64 * jj + key; return kp <= t && kp > t - 512; }
  DI int lo(int) const { return t - 511 - 64 * jj; }
  DI int hi(int) const { return t - 64 * jj; }
};
struct MobaMask {
  unsigned mq[2]; int tpos[2]; int ob; int w; int jj; bool s0, s1;
  DI bool skip(int j) const { return j > 4 * ob + w; }
  DI void set(int j) { jj = j; const int jb = j >> 2; s0 = (mq[0] >> jb) & 1u; s1 = (mq[1] >> jb) & 1u; }
  DI int mode(int j) const { const int jb = j >> 2; return jb < ob ? (__all(s0 && s1) ? 0 : 1) : ((j - 4 * ob == w) ? 2 : 0); }
  DI bool live(int qi) const { return qi == 0 ? s0 : s1; }
  DI bool vis(int qi, int key) const { return 64 * jj + key <= tpos[qi]; }
  DI int lo(int) const { return 0; }
  DI int hi(int qi) const { return tpos[qi] - 64 * jj; }
};

DI void load_q(const AttnLds& L, const act_t* qrow, int qi, int lane) {
  const int h = lane >> 5;
#pragma unroll
  for (int ks = 0; ks < 4; ++ks) {
    RawA r;
    bf16x8 hi, lo;
    raw_load(qrow + ks * 16 + h * 8, r);
    raw_frag<false>(r, hi, lo);
    *(bf16x8*)&L.Qs[((qi * 4 + ks) * 64 + lane) * 8] = hi;
  }
}

DI size_t late_row(int b, int t) { asm volatile("" : "+v"(t)); return (size_t)b * SEQ + t; }
DI void nsa_item(const Params& p, unsigned char* smem, int b, int qt) {
  int tid_ = threadIdx.x;
  asm volatile("" : "+v"(tid_));
  const int tid = tid_, lane = tid & 63, wave = __builtin_amdgcn_readfirstlane(tid >> 6), r32 = lane & 31, h = lane >> 5;
  AttnLds L;
  L.Ks = (bf16_t*)smem; L.Vs = (bf16_t*)(smem + KS_BYTES); L.Qs = (bf16_t*)(smem + KS_BYTES + VS_BYTES + wave * (QS_BYTES / 4));
  float* impsum = (float*)(smem + KS_BYTES + VS_BYTES + QS_BYTES);
  unsigned long long* selmask = (unsigned long long*)(impsum + 32 * 64);
  float* scr = (float*)(selmask + 32);
  const int t0 = qt * 32, cur = t0 >> 6, t = t0 + r32;
  const size_t tokrow = (size_t)b * SEQ + t;
#pragma unroll
  for (int qi = 0; qi < 2; ++qi) {
    const int hd = 2 * wave + qi;
    load_q(L, p.proj + tokrow * NP + hd * 64, qi, lane);
  }
  FlashSt st;
  flash_init(st);
  const int ncmp = (t0 >> 10) + 1;
  {
    CmpMask mg; mg.t = t; mg.t0 = t0; mg.jj = 0;
    run_branch(L, p.kc + (size_t)b * 256 * 64, 64, p.vcT + (size_t)b * 64 * 256, 256, 0, ncmp, mg, st, tid);
  }
  float mc[2], il[2];
#pragma unroll
  for (int qi = 0; qi < 2; ++qi) {
    const float lt = pair_sum32(st.l[qi]);
    const float inv = lt > 0.f ? 1.0f / lt : 0.f;
    mc[qi] = st.m[qi]; il[qi] = inv;
    const size_t row = late_row(b, t);
    const float gs = ldf(p.proj + row * NP + SLOT_GATE * 64 + 6 * wave + 3 * qi) * inv;
    float* dst = p.mixacc + row * 512 + (2 * wave + qi) * 64;
#pragma unroll
    for (int dt = 0; dt < 2; ++dt)
#pragma unroll
      for (int g = 0; g < 4; ++g)
        *(float4*)(dst + dt * 32 + 8 * g + 4 * h) = make_float4(st.o[qi][dt][4 * g] * gs, st.o[qi][dt][4 * g + 1] * gs, st.o[qi][dt][4 * g + 2] * gs, st.o[qi][dt][4 * g + 3] * gs);
  }
  unsigned long long msk;
  if (cur >= 16) {
    __syncthreads();
    for (int i = tid; i < 32 * 64; i += NTHREADS) impsum[i] = 0.f;
    RawA rkn[2];
    stage_k_load(p.kc + (size_t)b * 256 * 64, 64, tid, rkn);
    for (int j = 0; j < ncmp; ++j) {
      __syncthreads();
      stage_k_store(L, tid, rkn);
      __syncthreads();
      if (j + 1 < ncmp) stage_k_load(p.kc + (size_t)b * 256 * 64 + (size_t)(j + 1) * 64 * 64, 64, tid, rkn);
      f32x16 s[2][2];
      qk_tile(L, s, lane);
#pragma unroll
      for (int kt = 0; kt < 2; ++kt)
#pragma unroll
        for (int g = 0; g < 4; ++g) {
          float v4 = 0.f, v3 = 0.f;
#pragma unroll
          for (int e = 0; e < 4; ++e) {
            const int i = 4 * g + e;
            const int n = 64 * j + kt * 32 + crow(i, h);
            float pv = 0.f;
            if (16 * n + 31 <= t) pv = __builtin_amdgcn_exp2f(s[kt][0][i] - mc[0]) * il[0] + __builtin_amdgcn_exp2f(s[kt][1][i] - mc[1]) * il[1];
            v4 += pv;
            if (e == 3) v3 = pv;
          }
          const int bin = 16 * j + 8 * kt + 2 * g + h;
          atomicAdd((int*)&impsum[r32 * 64 + bin], __float2int_rn(v4 * 16777216.0f));
          if (bin + 1 < 64) atomicAdd((int*)&impsum[r32 * 64 + bin + 1], __float2int_rn(v3 * 16777216.0f));
        }
    }
    __syncthreads();
    for (int tt = 0; tt < 8; ++tt) {
      const int tok = wave * 8 + tt;
      const int jb = lane;
      const bool valid = jb <= cur;
      const bool forced = valid && (jb == 0 || jb == cur || jb == cur - 1);
      const float sc = forced ? INFINITY : (valid ? (float)((const int*)impsum)[tok * 64 + jb] : -INFINITY);
      int rank = 0;
#pragma unroll
      for (int i = 0; i < 64; ++i) {
        const float o = rlf(sc, i);
        const unsigned long long beat = __ballot(o > sc) | (__ballot(o == sc) & ~((2ull << i) - 1ull));
        asm("s_nop 1\n\tv_addc_co_u32_e64 %0, vcc, 0, %0, %1" : "+v"(rank) : "s"(beat) : "vcc");
      }
      const unsigned long long m = __ballot(rank < 16 && valid);
      if (lane == 0) selmask[tok] = m;
    }
    __syncthreads();
    msk = selmask[r32];
  } else {
    msk = (2ull << cur) - 1ull;
  }
  flash_init(st);
  {
    SlcMask mg; mg.msk = msk; mg.cur = cur; mg.t = t; mg.jj = 0; mg.sel = false;
    run_branch(L, p.proj + (size_t)b * SEQ * NP + SLOT_KSLC * 64, NP, p.vT_slc + (size_t)b * 64 * SEQ, SEQ, 0, cur + 1, mg, st, tid);
  }
#pragma unroll
  for (int qi = 0; qi < 2; ++qi) {
    const float lt = pair_sum32(st.l[qi]);
    const size_t row = late_row(b, t);
    const float gs = ldf(p.proj + row * NP + SLOT_GATE * 64 + 6 * wave + 3 * qi + 1) * (lt > 0.f ? 1.0f / lt : 0.f);
    float* dst = p.mixacc + row * 512 + (2 * wave + qi) * 64;
#pragma unroll
    for (int dt = 0; dt < 2; ++dt)
#pragma unroll
      for (int g = 0; g < 4; ++g) {
        float4* q4 = (float4*)(dst + dt * 32 + 8 * g + 4 * h);
        float4 v = *q4;
        v.x += st.o[qi][dt][4 * g] * gs; v.y += st.o[qi][dt][4 * g + 1] * gs; v.z += st.o[qi][dt][4 * g + 2] * gs; v.w += st.o[qi][dt][4 * g + 3] * gs;
        *q4 = v;
      }
  }
  flash_init(st);
  {
    WinMask mg; mg.t = t; mg.t0 = t0; mg.jj = 0;
    const int jlo = t0 >= 511 ? (t0 - 511) >> 6 : 0;
    run_branch(L, p.proj + (size_t)b * SEQ * NP + SLOT_KWIN * 64, NP, p.vT_win + (size_t)b * 64 * SEQ, SEQ, jlo, cur + 1, mg, st, tid);
  }
#pragma unroll
  for (int qi = 0; qi < 2; ++qi) {
    const float lt = pair_sum32(st.l[qi]);
    const size_t row = late_row(b, t);
    const float gs = ldf(p.proj + row * NP + SLOT_GATE * 64 + 6 * wave + 3 * qi + 2) * (lt > 0.f ? 1.0f / lt : 0.f);
    const float* src = p.mixacc + row * 512 + (2 * wave + qi) * 64;
    act_t* dst = p.mix + row * DM + (2 * wave + qi) * 64;
#if ORACLE
#pragma unroll
    for (int dt = 0; dt < 2; ++dt)
#pragma unroll
      for (int g = 0; g < 4; ++g) {
        const float4 v = *(const float4*)(src + dt * 32 + 8 * g + 4 * h);
        st4(dst + dt * 32 + 8 * g + 4 * h, v.x + st.o[qi][dt][4 * g] * gs, v.y + st.o[qi][dt][4 * g + 1] * gs, v.z + st.o[qi][dt][4 * g + 2] * gs, v.w + st.o[qi][dt][4 * g + 3] * gs);
      }
#else
#pragma unroll
    for (int dt = 0; dt < 2; ++dt)
#pragma unroll
      for (int g = 0; g < 4; g += 2) {
        const float4 v = *(const float4*)(src + dt * 32 + 8 * g + 4 * h);
        const float4 w = *(const float4*)(src + dt * 32 + 8 * g + 8 + 4 * h);
        st_pair16(dst + dt * 32 + 8 * g, h, v.x + st.o[qi][dt][4 * g] * gs, v.y + st.o[qi][dt][4 * g + 1] * gs, v.z + st.o[qi][dt][4 * g + 2] * gs, v.w + st.o[qi][dt][4 * g + 3] * gs,
                  w.x + st.o[qi][dt][4 * g + 4] * gs, w.y + st.o[qi][dt][4 * g + 5] * gs, w.z + st.o[qi][dt][4 * g + 6] * gs, w.w + st.o[qi][dt][4 * g + 7] * gs);
      }
#endif
  }
}

DI void moba_item(const Params& p, unsigned char* smem, int b, int hd, int ob) {
  int tid_ = threadIdx.x;
  asm volatile("" : "+v"(tid_));
  const int tid = tid_, lane = tid & 63, wave = __builtin_amdgcn_readfirstlane(tid >> 6), r32 = lane & 31, h = lane >> 5;
  AttnLds L;
  L.Ks = (bf16_t*)smem; L.Vs = (bf16_t*)(smem + KS_BYTES); L.Qs = (bf16_t*)(smem + KS_BYTES + VS_BYTES + wave * (QS_BYTES / 4));
  float* km = (float*)(smem + KS_BYTES + VS_BYTES + QS_BYTES);
  unsigned* msel = (unsigned*)(km + 16 * 64);
  __syncthreads();
  {
    float kv[4];
#pragma unroll
    for (int q = 0; q < 4; ++q) kv[q] = p.kmean[(size_t)(b * 8 + hd) * 16 * 64 + q * NTHREADS + tid];
#pragma unroll
    for (int q = 0; q < 4; ++q) km[q * NTHREADS + tid] = kv[q];
  }
  __syncthreads();
  {
    const act_t* qrow = p.proj + ((size_t)b * SEQ + ob * 256 + tid) * NP + (SLOT_MQ + hd) * 64;
    float gsc[16];
#pragma unroll
    for (int n = 0; n < 16; ++n) gsc[n] = 0.f;
    for (int dc = 0; dc < 64; dc += 8) {
      RawA r;
      raw_load(qrow + dc, r);
      float qv[8];
      raw_floats(r, qv);
#pragma unroll
      for (int n = 0; n < 16; ++n) {
        if (n < ob) {
#pragma unroll
          for (int j = 0; j < 8; ++j) gsc[n] += qv[j] * km[n * 64 + dc + j];
        }
      }
    }
    unsigned m = 0;
#pragma unroll
    for (int r = 0; r < 3; ++r) {
      float best = -INFINITY; int bi = -1;
#pragma unroll
      for (int n = 0; n < 16; ++n) {
        const bool ok = (n < ob) && !((m >> n) & 1u);
        if (ok && gsc[n] > best) { best = gsc[n]; bi = n; }
      }
      if (bi >= 0) m |= (1u << bi);
    }
    msel[tid] = m;
  }
  __syncthreads();
  MobaMask mg;
  mg.ob = ob; mg.w = wave; mg.jj = 0; mg.s0 = mg.s1 = false;
#pragma unroll
  for (int qi = 0; qi < 2; ++qi) {
    const int tl = 64 * wave + 32 * qi + r32;
    mg.mq[qi] = msel[tl];
    mg.tpos[qi] = ob * 256 + tl;
    load_q(L, p.proj + ((size_t)b * SEQ + ob * 256 + tl) * NP + (SLOT_MQ + hd) * 64, qi, lane);
  }
  FlashSt st;
  flash_init(st);
  run_branch(L, p.proj + (size_t)b * SEQ * NP + (SLOT_MK + hd) * 64, NP, p.vT_moba + (size_t)(b * 8 + hd) * 64 * SEQ, SEQ, 0, 4 * ob + 4, mg, st, tid);
#pragma unroll
  for (int qi = 0; qi < 2; ++qi) {
    const float lt = pair_sum32(st.l[qi]);
    const float inv = lt > 0.f ? 1.0f / lt : 0.f;
    act_t* dst = p.mix + ((size_t)b * SEQ + mg.tpos[qi]) * DM + 512 + hd * 64;
#if ORACLE
#pragma unroll
    for (int dt = 0; dt < 2; ++dt)
#pragma unroll
      for (int g = 0; g < 4; ++g)
        st4(dst + dt * 32 + 8 * g + 4 * h, st.o[qi][dt][4 * g] * inv, st.o[qi][dt][4 * g + 1] * inv, st.o[qi][dt][4 * g + 2] * inv, st.o[qi][dt][4 * g + 3] * inv);
#else
#pragma unroll
    for (int dt = 0; dt < 2; ++dt)
#pragma unroll
      for (int g = 0; g < 4; g += 2)
        st_pair16(dst + dt * 32 + 8 * g, h, st.o[qi][dt][4 * g] * inv, st.o[qi][dt][4 * g + 1] * inv, st.o[qi][dt][4 * g + 2] * inv, st.o[qi][dt][4 * g + 3] * inv,
                  st.o[qi][dt][4 * g + 4] * inv, st.o[qi][dt][4 * g + 5] * inv, st.o[qi][dt][4 * g + 6] * inv, st.o[qi][dt][4 * g + 7] * inv);
#endif
  }
}

DI void phase3(const Params& p, unsigned char* smem) {
  int& s_item = *(int*)(smem + SMEM_BYTES);
  for (;;) {
    __syncthreads();
    if (threadIdx.x == 0) s_item = atomicAdd(&p.ctr[0], 1);
    __syncthreads();
    const int n = __builtin_amdgcn_readfirstlane(s_item);
    if (n >= 1024) break;
    nsa_item(p, smem, n & 7, 127 - (n >> 3));
  }
  for (;;) {
    __syncthreads();
    if (threadIdx.x == 0) s_item = atomicAdd(&p.ctr[1], 1);
    __syncthreads();
    const int n = __builtin_amdgcn_readfirstlane(s_item);
    if (n >= 1024) break;
    moba_item(p, smem, (n & 63) >> 3, n & 7, 15 - (n >> 6));
  }
}

DI void phase4(const Params& p, unsigned char* smem) {
  const int tid = threadIdx.x, lane = tid & 63, wave = __builtin_amdgcn_readfirstlane(tid >> 6), wm = wave >> 1, wn = wave & 1, r32 = lane & 31, h = lane >> 5;
  const int vbid = (blockIdx.x & 7) * (gridDim.x >> 3) + (blockIdx.x >> 3);
  for (int tile = vbid; tile < 256 * 8; tile += gridDim.x) {
    const int mt = tile >> 3, nt = tile & 7, t0 = mt * 128, b = mt >> 5;
    AF_rows<act_t> af; af.src = p.mix + (size_t)t0 * DM; af.ld = DM;
    BT16 bp; bp.w = p.woutT; bp.wlo = p.woutTl; bp.ldk = DM; bp.n0 = nt * 128;
    f32x16 acc[2][2];
#if ORACLE
    gemm_core<kSplit, 0, AF_rows<act_t>, BT16, true>(smem, DM, af, bp, acc);
#else
    { AP_rows ap; ap.src = af.src; ap.ld = DM; gemm_core_gg<0, AP_rows, true>(smem, DM, ap, p.woutT, DM, nt * 128, acc); }
#endif
    {
      float* T = (float*)smem;
#pragma unroll 1
      for (int pass = 0; pass < 2; ++pass) {
        if (wm == pass) {
#if ORACLE
#pragma unroll
          for (int mi = 0; mi < 2; ++mi)
#pragma unroll
            for (int ni = 0; ni < 2; ++ni)
#pragma unroll
              for (int i = 0; i < 16; ++i) T[(mi * 32 + crow(i, h)) * 132 + wn * 64 + ni * 32 + r32] = acc[mi][ni][i];
#else
#pragma unroll
          for (int mi = 0; mi < 2; ++mi)
#pragma unroll
            for (int ni = 0; ni < 2; ++ni)
#pragma unroll
              for (int g = 0; g < 4; ++g)
                *(float4*)&T[(mi * 32 + r32) * 132 + wn * 64 + ni * 32 + 8 * g + 4 * h] =
                    make_float4(acc[mi][ni][4 * g], acc[mi][ni][4 * g + 1], acc[mi][ni][4 * g + 2], acc[mi][ni][4 * g + 3]);
#endif
        }
        __syncthreads();
        {
          const int cc = (tid & 31) * 4, r0 = tid >> 5;
          const float4 gt = *(const float4*)(p.mod + b * 6144 + 2048 + nt * 128 + cc);
          float4 xv[8];
#pragma unroll
          for (int q = 0; q < 8; ++q) xv[q] = *(const float4*)(p.x + (size_t)(t0 + pass * 64 + r0 + 8 * q) * DM + nt * 128 + cc);
#pragma unroll
          for (int q = 0; q < 8; ++q) {
            const int row = r0 + 8 * q;
            const float4 v = *(const float4*)&T[row * 132 + cc];
            __builtin_nontemporal_store(make_f32x4(xv[q].x + gt.x * v.x, xv[q].y + gt.y * v.y, xv[q].z + gt.z * v.z, xv[q].w + gt.w * v.w),
                                        (f32x4*)(p.hres + (size_t)(t0 + pass * 64 + row) * DM + nt * 128 + cc));
          }
        }
        __syncthreads();
      }
    }
  }
}

#if ORACLE
DI void phase5pre(const Params& p) {
  const int tid = otid(), lane = tid & 63, wave = __builtin_amdgcn_readfirstlane(tid >> 6);
  const int gw = blockIdx.x * 4 + wave, nw = gridDim.x * 4;
  for (int tok = gw; tok < NT; tok += nw) {
    const int b = tok >> 12;
    const float* xr = p.hres + (size_t)tok * DM;
    float4 xv[4];
    float ss = 0.f;
#pragma unroll
    for (int j = 0; j < 4; ++j) {
      xv[j] = *(const float4*)(xr + lane * 4 + 256 * j);
      ss += xv[j].x * xv[j].x + xv[j].y * xv[j].y + xv[j].z * xv[j].z + xv[j].w * xv[j].w;
    }
    ss = wave_sum(ss);
    const float rsv = 1.0f / sqrtf(ss * (1.0f / DM) + 1e-6f);
#pragma unroll
    for (int j = 0; j < 4; ++j) {
      const int c = lane * 4 + 256 * j;
      const float4 g = *(const float4*)(p.g_ffn + c);
      const float4 sc = *(const float4*)(p.mod + b * 6144 + 4096 + c);
      const float4 sh = *(const float4*)(p.mod + b * 6144 + 3072 + c);
      const float v0 = xv[j].x * rsv * (g.x * (1.0f + sc.x)) + sh.x, v1 = xv[j].y * rsv * (g.y * (1.0f + sc.y)) + sh.y;
      const float v2 = xv[j].z * rsv * (g.z * (1.0f + sc.z)) + sh.z, v3 = xv[j].w * rsv * (g.w * (1.0f + sc.w)) + sh.w;
      st4(p.h2 + (size_t)tok * DM + c, v0, v1, v2, v3);
#if !ORACLE
      const float h0 = bf2f(f2bf(v0)), h1 = bf2f(f2bf(v1)), h2_ = bf2f(f2bf(v2)), h3 = bf2f(f2bf(v3));
      st4(p.h2lo + (size_t)tok * DM + c, v0 - h0, v1 - h1, v2 - h2_, v3 - h3);
#endif
    }
  }
#if ORACLE
  {
    float4* ya = (float4*)p.yacc;
    const size_t n4 = (size_t)NT * DM / 4;
    for (size_t i = (size_t)blockIdx.x * NTHREADS + tid; i < n4; i += (size_t)gridDim.x * NTHREADS) ya[i] = make_float4(0, 0, 0, 0);
  }
#endif
}
#else
DI void phase5pre(const Params& p) {
  const int tid = otid(), lane = tid & 63, wave = __builtin_amdgcn_readfirstlane(tid >> 6);
  const int gw = blockIdx.x * 4 + wave, nw = gridDim.x * 4;
  for (int tok = gw; tok < NT; tok += nw) {
    const int b = tok >> 12;
    const float* xr = p.hres + (size_t)tok * DM;
    float xv[16];
    float ss = 0.f;
#pragma unroll
    for (int j = 0; j < 2; ++j) {
      const float4 a0 = *(const float4*)(xr + lane * 8 + 512 * j), a1 = *(const float4*)(xr + lane * 8 + 512 * j + 4);
      float* xx = xv + 8 * j;
      xx[0] = a0.x; xx[1] = a0.y; xx[2] = a0.z; xx[3] = a0.w; xx[4] = a1.x; xx[5] = a1.y; xx[6] = a1.z; xx[7] = a1.w;
#pragma unroll
      for (int q = 0; q < 8; ++q) ss += xx[q] * xx[q];
    }
    ss = wave_sum(ss);
    const float rsv = 1.0f / sqrtf(ss * (1.0f / DM) + 1e-6f);
#pragma unroll
    for (int j = 0; j < 2; ++j) {
      const int c = lane * 8 + 512 * j;
      float o[8], ol[8];
#pragma unroll
      for (int hh = 0; hh < 2; ++hh) {
        const float4 g = *(const float4*)(p.g_ffn + c + 4 * hh);
        const float4 sc = *(const float4*)(p.mod + b * 6144 + 4096 + c + 4 * hh);
        const float4 sh = *(const float4*)(p.mod + b * 6144 + 3072 + c + 4 * hh);
        const float* xx = xv + 8 * j + 4 * hh;
        o[4 * hh] = xx[0] * rsv * (g.x * (1.0f + sc.x)) + sh.x; o[4 * hh + 1] = xx[1] * rsv * (g.y * (1.0f + sc.y)) + sh.y;
        o[4 * hh + 2] = xx[2] * rsv * (g.z * (1.0f + sc.z)) + sh.z; o[4 * hh + 3] = xx[3] * rsv * (g.w * (1.0f + sc.w)) + sh.w;
      }
#pragma unroll
      for (int q = 0; q < 8; ++q) ol[q] = o[q] - bf2f(f2bf(o[q]));
      st8bf(p.h2 + (size_t)tok * DM + c, o);
      st8bf(p.h2lo + (size_t)tok * DM + c, ol);
    }
  }
}
#endif

DI void phase5a(const Params& p, unsigned char* smem) {
  const int tid = threadIdx.x, lane = tid & 63, wave = __builtin_amdgcn_readfirstlane(tid >> 6), wm = wave >> 1, wn = wave & 1, r32 = lane & 31, h = lane >> 5;
  for (int tile = blockIdx.x; tile < 512; tile += gridDim.x) {
    const int mt = tile >> 1, nt = tile & 1, t0 = mt * 128;
#if ORACLE
    AF_rows<act_t> af; af.src = p.h2 + (size_t)t0 * DM; af.ld = DM;
#else
    AF_hl af; af.hi = p.h2 + (size_t)t0 * DM; af.lo = p.h2lo + (size_t)t0 * DM; af.ld = DM;
#endif
    BT16 bp; bp.w = p.wrT; bp.wlo = p.wrTl; bp.ldk = DM; bp.n0 = nt * 128;
    f32x16 acc[2][2];
    gemm_core<true, 0>(smem, DM, af, bp, acc);
#pragma unroll
    for (int mi = 0; mi < 2; ++mi)
#pragma unroll
      for (int ni = 0; ni < 2; ++ni)
#pragma unroll
        for (int i = 0; i < 16; ++i) {
          const int r = t0 + wm * 64 + mi * 32 + crow(i, h);
          p.scores[(size_t)r * 256 + nt * 128 + wn * 64 + ni * 32 + r32] = sigmoidf_(acc[mi][ni][i]);
        }
  }
}

DI void phase5b(const Params& p) {
  const int tid = otid(), lane = tid & 63, wave = __builtin_amdgcn_readfirstlane(tid >> 6);
  const int gw = blockIdx.x * 4 + wave, nw = gridDim.x * 4;
  const float4 bias4 = *(const float4*)(p.router_bias + 4 * lane);
  float4 s4n = make_float4(0.f, 0.f, 0.f, 0.f);
  if (gw < NT) s4n = *(const float4*)(p.scores + (size_t)gw * 256 + 4 * lane);
  int rk_prev = 0, e_prev = 0, tok_prev = -1;
  for (int tok = gw; tok < NT; tok += nw) {
    const float4 s4 = s4n;
    if (tok + nw < NT) s4n = *(const float4*)(p.scores + (size_t)(tok + nw) * 256 + 4 * lane);
    const float sc0 = s4.x, sc1 = s4.y, sc2 = s4.z, sc3 = s4.w;
    const float b0 = sc0 + bias4.x, b1 = sc1 + bias4.y, b2 = sc2 + bias4.z, b3 = sc3 + bias4.w;
    float m1 = fmaxf(b0, b1), m2 = fminf(b0, b1);
    { const float n1 = fmaxf(m1, b2), n2 = fmaxf(fminf(m1, b2), m2); m1 = n1; m2 = n2; }
    { const float n1 = fmaxf(m1, b3), n2 = fmaxf(fminf(m1, b3), m2); m1 = n1; m2 = n2; }
    { const float o1 = dppf<DPP_XOR1>(m1), o2 = dppf<DPP_XOR1>(m2); const float n1 = fmaxf(m1, o1), n2 = fmaxf(fminf(m1, o1), fmaxf(m2, o2)); m1 = n1; m2 = n2; }
    { const float o1 = dppf<DPP_XOR2>(m1), o2 = dppf<DPP_XOR2>(m2); const float n1 = fmaxf(m1, o1), n2 = fmaxf(fminf(m1, o1), fmaxf(m2, o2)); m1 = n1; m2 = n2; }
    { const float o1 = dppf<DPP_HMIRROR>(m1), o2 = dppf<DPP_HMIRROR>(m2); const float n1 = fmaxf(m1, o1), n2 = fmaxf(fminf(m1, o1), fmaxf(m2, o2)); m1 = n1; m2 = n2; }
    const float gs = m1 + m2;
    const int g = lane >> 3;
    int rank = 0;
#pragma unroll
    for (int gg = 0; gg < 8; ++gg) {
      const float v = rlf(gs, gg * 8);
      rank += (v > gs || (v == gs && gg < g)) ? 1 : 0;
    }
    const bool gsel = rank < 4;
    float c0 = gsel ? b0 : -INFINITY, c1 = gsel ? b1 : -INFINITY, c2 = gsel ? b2 : -INFINITY, c3 = gsel ? b3 : -INFINITY;
    int mye = 0; float mys = 0.f, ssum = 0.f;
#pragma unroll
    for (int r = 0; r < 8; ++r) {
      float lb = c0; int lj = 0;
      { const bool t = c1 > lb; lb = t ? c1 : lb; lj = t ? 1 : lj; }
      { const bool t = c2 > lb; lb = t ? c2 : lb; lj = t ? 2 : lj; }
      { const bool t = c3 > lb; lb = t ? c3 : lb; lj = t ? 3 : lj; }
      const float w = row_max16(lb);
      const float wmax = fmaxf(fmaxf(rlf(w, 0), rlf(w, 16)), fmaxf(rlf(w, 32), rlf(w, 48)));
      const unsigned long long owners = __ballot(lb == wmax);
      const int ol = __builtin_amdgcn_readfirstlane((int)__ffsll((long long)owners) - 1);
      float mine = sc0;
      mine = (lj == 1) ? sc1 : mine; mine = (lj == 2) ? sc2 : mine; mine = (lj == 3) ? sc3 : mine;
      const int oj = __builtin_amdgcn_readlane(lj, ol);
      const float ws = rlf(mine, ol);
      const bool own = lane == ol;
      c0 = (own && oj == 0) ? -INFINITY : c0; c1 = (own && oj == 1) ? -INFINITY : c1;
      c2 = (own && oj == 2) ? -INFINITY : c2; c3 = (own && oj == 3) ? -INFINITY : c3;
      ssum += ws;
      if (lane == r) { mye = 4 * ol + oj; mys = ws; }
    }
    if (lane < 8) {
      if (tok_prev >= 0) p.list[(size_t)e_prev * CAP + rk_prev] = tok_prev * NSLOT + lane;
      const float w = mys / ssum * 2.5f;
      rk_prev = atomicAdd(&p.cnt[mye * CNT_STRIDE], 1);
      e_prev = mye;
      p.selw[tok * NSLOT + lane] = w;
    }
    tok_prev = tok;
  }
  if (lane < 8 && tok_prev >= 0) p.list[(size_t)e_prev * CAP + rk_prev] = tok_prev * NSLOT + lane;
}

struct AF_gather {
  typedef typename RawOf<act_t>::type Raw;
  const act_t* h2; const int* rowtok;
  DI void load(int row, int k, Raw& r) const {
    const int tk = max(rowtok[row], 0);
    raw_load(h2 + (size_t)tk * DM + k, r);
  }
  DI void cvt(const Raw& r, int row, int k, bf16x8& hi, bf16x8& lo) const { raw_frag<kSplit>(r, hi, lo); }
};

#define BIG6X (!ORACLE)
#if !ORACLE
constexpr int G4_STAGE = 24576;
template <int NMAP, bool SWP = false>
DI void gemm_compute_g4(const unsigned char* As, const unsigned char* Bs, f32x16 (&acc)[4][2], int wm, int wn, int r32, int h) {
  const int sw = (r32 >> 2) & 3;
#pragma unroll 1
  for (int ks = 0; ks < 2; ++ks) {
    const int pc = ((ks * 2 + h) ^ sw) << 4;
    bf16x8 a[4], b[2];
#pragma unroll
    for (int mi = 0; mi < 4; ++mi) a[mi] = *(const bf16x8*)(As + (wm * 128 + mi * 32 + r32) * 64 + pc);
#pragma unroll
    for (int ni = 0; ni < 2; ++ni) {
      const int nrow = (NMAP == 0) ? (wn * 64 + ni * 32) : (ni == 0 ? wn * 32 : 64 + wn * 32);
      b[ni] = *(const bf16x8*)(Bs + (nrow + r32) * 64 + pc);
    }
#pragma unroll
    for (int ni = 0; ni < 2; ++ni)
#pragma unroll
      for (int mi = 0; mi < 4; ++mi) acc[mi][ni] = SWP ? MFMA(b[ni], a[mi], acc[mi][ni]) : MFMA(a[mi], b[ni], acc[mi][ni]);
  }
}
constexpr int G4_BOFF = 2 * 16384, G4_BSUPER = 16384, G4_LDS = G4_BOFF + 2 * G4_BSUPER;
template <int NMAP, class AP, bool SWP = false>
DI void gemm_core_gf4(unsigned char* smem, int K, const AP& ap, const float* wa, const float* wb, int ldb, int ca, int cb, f32x16 (&acc)[4][2]) {
  const int tid = otid(), lane = tid & 63, wave = __builtin_amdgcn_readfirstlane(tid >> 6), wm = wave >> 1, wn = wave & 1, r32 = lane & 31, h = lane >> 5;
#pragma unroll
  for (int mi = 0; mi < 4; ++mi)
#pragma unroll
    for (int ni = 0; ni < 2; ++ni)
#pragma unroll
      for (int i = 0; i < 16; ++i) acc[mi][ni][i] = 0.f;
  const int grow = tid >> 2, gc = ((tid & 3) ^ ((tid >> 4) & 3)) * 8;
  const unsigned a0 = (ap.rowoff(grow) + gc) * 2u, a1 = (ap.rowoff(grow + 64) + gc) * 2u, a2 = (ap.rowoff(grow + 128) + gc) * 2u, a3 = (ap.rowoff(grow + 192) + gc) * 2u;
  const bf16_t* sb; { unsigned long long u = (unsigned long long)ap.base();
    u = ((unsigned long long)(unsigned)__builtin_amdgcn_readfirstlane((int)(u >> 32)) << 32) | (unsigned)__builtin_amdgcn_readfirstlane((int)u); sb = (const bf16_t*)u; }
  const int c4 = tid & 15, bh = (tid >> 4) & 1, kq = tid >> 5;
  const float* bbase = (bh ? (wb + cb) : (wa + ca)) + 4 * c4 + (size_t)(8 * kq) * ldb;
  const int bo = (kq >> 2) * 8192;
  const int brow = bh * 64 + 4 * c4;
  const unsigned wbase = __builtin_amdgcn_readfirstlane(lds_off(smem) + wave * 1024);
  float4 rb[8];
  auto bload = [&](int k0) {
#pragma unroll
    for (int j = 0; j < 8; ++j) rb[j] = *(const float4*)(bbase + (size_t)(k0 + j) * ldb);
  };
  auto bstore = [&](unsigned char* Bs) {
    bf16x8 hi, lo;
    float v[8];
#pragma unroll
    for (int j = 0; j < 8; ++j) v[j] = rb[j].x;
    cvt8<false>(v, hi, lo); *(bf16x8*)(Bs + bo + swz_off(brow, kq & 3)) = hi;
#pragma unroll
    for (int j = 0; j < 8; ++j) v[j] = rb[j].y;
    cvt8<false>(v, hi, lo); *(bf16x8*)(Bs + bo + swz_off(brow + 1, kq & 3)) = hi;
#pragma unroll
    for (int j = 0; j < 8; ++j) v[j] = rb[j].z;
    cvt8<false>(v, hi, lo); *(bf16x8*)(Bs + bo + swz_off(brow + 2, kq & 3)) = hi;
#pragma unroll
    for (int j = 0; j < 8; ++j) v[j] = rb[j].w;
    cvt8<false>(v, hi, lo); *(bf16x8*)(Bs + bo + swz_off(brow + 3, kq & 3)) = hi;
  };
  glds16_s(a0, sb, wbase); glds16_s(a1, sb, wbase + 4096); glds16_s(a2, sb, wbase + 8192); glds16_s(a3, sb, wbase + 12288);
  { const bf16_t* sk = sb + 32; const unsigned d2 = wbase + 16384;
    glds16_s(a0, sk, d2); glds16_s(a1, sk, d2 + 4096); glds16_s(a2, sk, d2 + 8192); glds16_s(a3, sk, d2 + 12288); }
  bload(0);
  bstore(smem + G4_BOFF);
  asm volatile("s_waitcnt vmcnt(0)" ::: "memory");
  __syncthreads();
  const int nS = K >> 6;
#pragma unroll 1
  for (int S = 0; S < nS; ++S) {
    const bool more = S + 1 < nS;
    const int k0 = S * 64;
    unsigned char* Bcur = smem + G4_BOFF + (S & 1) * G4_BSUPER;
    if (S > 0) { const unsigned d2 = wbase + 16384;
      const bf16_t* sk = sb + k0 + 32;
      glds16_s(a0, sk, d2); glds16_s(a1, sk, d2 + 4096); glds16_s(a2, sk, d2 + 8192); glds16_s(a3, sk, d2 + 12288); }
    if (more) bload(k0 + 64);
    gemm_compute_g4<NMAP, SWP>(smem, Bcur, acc, wm, wn, r32, h);
    if (more) asm volatile("s_waitcnt vmcnt(8)" ::: "memory");
    else asm volatile("s_waitcnt vmcnt(0)" ::: "memory");
    __syncthreads();
    if (more) {
#pragma unroll
      for (int j = 0; j < 8; ++j) asm volatile("" :: "v"(rb[j].x), "v"(rb[j].y), "v"(rb[j].z), "v"(rb[j].w));
      const bf16_t* sk = sb + k0 + 64;
      glds16_s(a0, sk, wbase); glds16_s(a1, sk, wbase + 4096); glds16_s(a2, sk, wbase + 8192); glds16_s(a3, sk, wbase + 12288);
      bstore(smem + G4_BOFF + ((S + 1) & 1) * G4_BSUPER);
    }
    gemm_compute_g4<NMAP, SWP>(smem + 16384, Bcur + 8192, acc, wm, wn, r32, h);
    asm volatile("s_waitcnt vmcnt(0)" ::: "memory");
    __syncthreads();
  }
}

DI int expert_tile_prefix(const Params& p, int* pre, int tid) {
  const int lane = tid & 63, wave = tid >> 6;
  int* wsum = pre + 260;
  __syncthreads();
  const int craw = p.cnt[tid * CNT_STRIDE];
  const int mine = (craw + 255) >> 8;
  int v = mine;
#pragma unroll
  for (int o = 1; o < 64; o <<= 1) { const int u = __shfl_up(v, o); if (lane >= o) v += u; }
  if (lane == 63) wsum[wave] = v;
  __syncthreads();
  int off = 0;
#pragma unroll
  for (int w = 0; w < 3; ++w) off += (w < wave) ? wsum[w] : 0;
  pre[tid] = (off + v - mine) | (craw << 16);
  if (tid == NEXP - 1) { pre[NEXP] = off + v; pre[NEXP + 1] = off + v + 128; }
  __syncthreads();
  return __builtin_amdgcn_readfirstlane(pre[NEXP + 1]);
}
DI void expert_tile_lookup(const int* pre, int ti, int& e, int& mt, int& nrows) {
  int lo = 0, hi = NEXP;
  while (lo < hi) { const int mid = (lo + hi + 1) >> 1; if ((pre[mid] & 0xFFFF) <= ti) lo = mid; else hi = mid - 1; }
  const int pv = pre[lo];
  e = __builtin_amdgcn_readfirstlane(lo); mt = __builtin_amdgcn_readfirstlane(ti - (pv & 0xFFFF));
  nrows = __builtin_amdgcn_readfirstlane((int)((unsigned)pv >> 16));
}

DI void expert_item_table(const int* pre, int* itab, int vbid, int total, int shift, int tid) {
  if (tid < 32) {
    const int it = vbid + tid * (int)gridDim.x;
    int v = 0;
    if (it < total) {
      const int ti = it >> shift;
      int lo = 0, hi = NEXP;
      while (lo < hi) { const int mid = (lo + hi + 1) >> 1; if ((pre[mid] & 0xFFFF) <= ti) lo = mid; else hi = mid - 1; }
      v = lo | ((ti - (pre[lo] & 0xFFFF)) << 16);
    }
    itab[tid] = v;
  }
  __syncthreads();
}
DI void expert_item_get(const int* pre, const int* itab, int j, int& e, int& mt, int& nrows) {
  const int v = __builtin_amdgcn_readfirstlane(itab[j]);
  e = v & 0xFFFF; mt = v >> 16;
  nrows = __builtin_amdgcn_readfirstlane((int)((unsigned)pre[e] >> 16));
}

DI void phase6a(const Params& p, unsigned char* smem) {
  const int tid = otid(), lane = tid & 63, wave = __builtin_amdgcn_readfirstlane(tid >> 6), wm = wave >> 1, wn = wave & 1, r32 = lane & 31, h = lane >> 5;
  constexpr int TBL = G4_LDS;
  int* pre = (int*)(smem + TBL);
  int* rowtok = pre + 260;
  const int ntiles = expert_tile_prefix(p, pre, tid);
  const int total = ntiles * 4;
  const int vbid = (blockIdx.x & 7) * (gridDim.x >> 3) + (blockIdx.x >> 3);
  int* itab = rowtok + 256;
  expert_item_table(pre, itab, vbid, total, 2, tid);
  int e_n = 0, mt_n = 0, tk_n = -1;
  auto fetch_rows = [&](int it) {
    int nr_n;
    expert_item_get(pre, itab, (it - vbid) / (int)gridDim.x, e_n, mt_n, nr_n);
    tk_n = -1;
    if (e_n < NEXP) {
      const int idx = mt_n * 256 + tid;
      if (idx < nr_n) tk_n = p.list[(size_t)e_n * CAP + idx] / NSLOT;
    } else {
      tk_n = mt_n * 256 + tid;
    }
  };
  if (vbid < total) fetch_rows(vbid);
  for (int item = vbid; item < total; item += gridDim.x) {
    const int ti = item >> 2, nt = item & 3;
    const int e = e_n;
    __syncthreads();
    rowtok[tid] = tk_n;
    __syncthreads();
    if (item + (int)gridDim.x < total) fetch_rows(item + gridDim.x);
    const float* wg = e < NEXP ? p.w_eg + (size_t)e * DM * 256 : p.w_sg;
    const float* wu = e < NEXP ? p.w_eu + (size_t)e * DM * 256 : p.w_su;
    f32x16 acc[4][2];
    { AP_gather ap; ap.h2 = p.h2; ap.rowtok = rowtok; gemm_core_gf4<1, AP_gather, true>(smem, DM, ap, wg, wu, 256, nt * 64, nt * 64, acc); }
    bf16_t* T = (bf16_t*)smem;
#pragma unroll
    for (int mi = 0; mi < 4; ++mi)
#pragma unroll
      for (int g = 0; g < 4; ++g) {
        u32x2 u;
        u[0] = pack2bf(siluf_fast(acc[mi][0][4 * g]) * acc[mi][1][4 * g], siluf_fast(acc[mi][0][4 * g + 1]) * acc[mi][1][4 * g + 1]);
        u[1] = pack2bf(siluf_fast(acc[mi][0][4 * g + 2]) * acc[mi][1][4 * g + 2], siluf_fast(acc[mi][0][4 * g + 3]) * acc[mi][1][4 * g + 3]);
        *(u32x2*)&T[(wm * 128 + mi * 32 + r32) * 72 + wn * 32 + 8 * g + 4 * h] = u;
      }
    __syncthreads();
    bf16_t* dstb = p.abuf + (size_t)ti * 256 * 256 + nt * 64;
    { auto rp = [&](int r) { return dstb + (size_t)r * 256; }; epi_flush_bf16<8, decltype(rp), true>(T, 72, 256, rp); }
  }
}

DI void phase6b(const Params& p, unsigned char* smem) {
  const int tid = otid(), lane = tid & 63, wave = __builtin_amdgcn_readfirstlane(tid >> 6), wm = wave >> 1, wn = wave & 1, r32 = lane & 31, h = lane >> 5;
  constexpr int TBL = SMEM_BYTES - 3328;
  static_assert(TBL >= 256 * 136 * 2 && TBL >= G4_LDS, "6b LDS plan");
  int* pre = (int*)(smem + TBL);
  int* rowslot = pre + 260;
  float* roww = (float*)(rowslot + 256);
  const int ntiles = expert_tile_prefix(p, pre, tid);
  const int total = ntiles * 8;
  const int vbid = (blockIdx.x & 7) * (gridDim.x >> 3) + (blockIdx.x >> 3);
  int* itab = (int*)(roww + 256);
  static_assert((260 + 256 + 256 + 32) * 4 <= 3328, "6b table space");
  expert_item_table(pre, itab, vbid, total, 3, tid);
  int e_n = 0, mt_n = 0, slot_n = -1; float w_n = 0.f;
  auto fetch_rows = [&](int it) {
    int nr_n;
    expert_item_get(pre, itab, (it - vbid) / (int)gridDim.x, e_n, mt_n, nr_n);
    slot_n = -1; w_n = 0.f;
    if (e_n < NEXP) {
      const int idx = mt_n * 256 + tid;
      if (idx < nr_n) { slot_n = p.list[(size_t)e_n * CAP + idx]; w_n = p.selw[slot_n]; }
    } else {
      slot_n = (mt_n * 256 + tid) * NSLOT + 8; w_n = 1.0f;
    }
  };
  if (vbid < total) fetch_rows(vbid);
  for (int item = vbid; item < total; item += gridDim.x) {
    const int ti = item >> 3, nt = item & 7;
    const int e = e_n;
    __syncthreads();
    rowslot[tid] = slot_n; roww[tid] = w_n;
    __syncthreads();
    if (item + (int)gridDim.x < total) fetch_rows(item + gridDim.x);
    const float* wd = e < NEXP ? p.w_ed + (size_t)e * 256 * DM : p.w_sd;
    f32x16 acc[4][2];
    { AP_rows ap; ap.src = p.abuf + (size_t)ti * 256 * 256; ap.ld = 256; gemm_core_gf4<0, AP_rows, true>(smem, 256, ap, wd, wd, DM, nt * 128, nt * 128 + 64, acc); }
    bf16_t* T = (bf16_t*)smem;
    bf16_t* yb = p.yslots + nt * 128;
#pragma unroll 1
    for (int pass = 0; pass < 2; ++pass) {
      int ps = pass;
      asm volatile("" : "+s"(ps));
      if (wm == ps) {
#pragma unroll
        for (int mi = 0; mi < 4; ++mi) {
          const int rl = pass * 128 + mi * 32 + r32;
          const float w = roww[rl];
#pragma unroll
          for (int ni = 0; ni < 2; ++ni)
#pragma unroll
            for (int g = 0; g < 4; ++g) {
              u32x2 u;
              u[0] = pack2bf(acc[mi][ni][4 * g] * w, acc[mi][ni][4 * g + 1] * w);
              u[1] = pack2bf(acc[mi][ni][4 * g + 2] * w, acc[mi][ni][4 * g + 3] * w);
              *(u32x2*)&T[rl * 136 + wn * 64 + ni * 32 + 8 * g + 4 * h] = u;
            }
        }
      }
    }
    __syncthreads();
#pragma unroll 1
    for (int hf = 0; hf < 2; ++hf) {
      auto rp = [&](int r) { const int slot = rowslot[hf * 128 + r]; return slot >= 0 ? yb + (size_t)slot * DM : (bf16_t*)nullptr; };
      epi_flush_bf16<16, decltype(rp), true>(T + hf * 128 * 136, 136, 128, rp);
    }
  }
}
#else
DI void phase6(const Params& p, unsigned char* smem) {
  const int tid = threadIdx.x, lane = tid & 63, wave = __builtin_amdgcn_readfirstlane(tid >> 6), wm = wave >> 1, wn = wave & 1, r32 = lane & 31, h = lane >> 5;
  int* pre = (int*)(smem + GEMM_LDS);
  int* rowslot = pre + 260;
  int* rowtok = rowslot + 128;
  float* roww = (float*)(rowtok + 128);
  __syncthreads();
  if (tid == 0) {
    int s = 0;
    for (int e = 0; e < NEXP; ++e) { pre[e] = s; s += (p.cnt[e * CNT_STRIDE] + 127) >> 7; }
    pre[NEXP] = s; s += 256; pre[NEXP + 1] = s;
  }
  __syncthreads();
  const int total = __builtin_amdgcn_readfirstlane(pre[NEXP + 1]);
  act_t* ab = p.abuf + (size_t)blockIdx.x * 128 * 256;
  const int vbid = (blockIdx.x & 7) * (gridDim.x >> 3) + (blockIdx.x >> 3);
  for (int item = vbid; item < total; item += gridDim.x) {
    int lo = 0, hi = NEXP;
    while (lo < hi) { const int mid = (lo + hi + 1) >> 1; if (pre[mid] <= item) lo = mid; else hi = mid - 1; }
    const int e = __builtin_amdgcn_readfirstlane(lo), mt = __builtin_amdgcn_readfirstlane(item - pre[lo]);
    __syncthreads();
    if (tid < 128) {
      int slot = -1; float w = 0.f;
      if (e < NEXP) {
        const int idx = mt * 128 + tid;
        if (idx < p.cnt[e * CNT_STRIDE]) { slot = p.list[(size_t)e * CAP + idx]; w = p.selw[slot]; }
      } else {
        slot = (mt * 128 + tid) * NSLOT + 8; w = 1.0f;
      }
      rowslot[tid] = slot; rowtok[tid] = slot >= 0 ? slot / NSLOT : -1; roww[tid] = w;
    }
    __syncthreads();
    const float* wg = e < NEXP ? p.w_eg + (size_t)e * DM * 256 : p.w_sg;
    const float* wu = e < NEXP ? p.w_eu + (size_t)e * DM * 256 : p.w_su;
    const float* wd = e < NEXP ? p.w_ed + (size_t)e * 256 * DM : p.w_sd;
#pragma unroll 1
    for (int nt = 0; nt < 4; ++nt) {
      AF_gather af; af.h2 = p.h2; af.rowtok = rowtok;
      BF32 bp; bp.wa = wg; bp.wb = wu; bp.ldb = 256; bp.ca = nt * 64; bp.cb = nt * 64;
      f32x16 acc[2][2];
#if ORACLE
      gemm_core<kSplit, 1>(smem, DM, af, bp, acc);
#else
      { AP_gather ap; ap.h2 = p.h2; ap.rowtok = rowtok; gemm_core_gf<1>(smem, DM, ap, wg, wu, 256, nt * 64, nt * 64, acc); }
#endif
#if ORACLE
#pragma unroll
      for (int mi = 0; mi < 2; ++mi)
#pragma unroll
        for (int i = 0; i < 16; ++i) {
          const int r = wm * 64 + mi * 32 + crow(i, h);
          const int cc = nt * 64 + wn * 32 + r32;
          st1(ab + (size_t)r * 256 + cc, siluf_(acc[mi][0][i]) * acc[mi][1][i]);
        }
#else
      {
        bf16_t* T = (bf16_t*)smem;
#pragma unroll
        for (int mi = 0; mi < 2; ++mi)
#pragma unroll
          for (int i = 0; i < 16; ++i)
            T[(wm * 64 + mi * 32 + crow(i, h)) * 72 + wn * 32 + r32] = f2bf(siluf_(acc[mi][0][i]) * acc[mi][1][i]);
        __syncthreads();
        bf16_t* dstb = ab + nt * 64;
        epi_flush_bf16<8>(T, 72, 128, [&](int r) { return dstb + (size_t)r * 256; });
        __syncthreads();
      }
#endif
    }
    __threadfence_block();
    __syncthreads();
#pragma unroll 1
    for (int nt = 0; nt < 8; ++nt) {
      AF_rows<act_t> af; af.src = ab; af.ld = 256;
      BF32 bp; bp.wa = wd; bp.wb = wd; bp.ldb = DM; bp.ca = nt * 128; bp.cb = nt * 128 + 64;
      f32x16 acc[2][2];
#if ORACLE
      gemm_core<kSplit, 0>(smem, 256, af, bp, acc);
#else
      { AP_rows ap; ap.src = ab; ap.ld = 256; gemm_core_gf<0>(smem, 256, ap, wd, wd, DM, nt * 128, nt * 128 + 64, acc); }
#endif
#if ORACLE
#pragma unroll
      for (int mi = 0; mi < 2; ++mi)
#pragma unroll
        for (int i = 0; i < 16; ++i) {
          const int r = wm * 64 + mi * 32 + crow(i, h);
          const int slot = rowslot[r];
          if (slot >= 0) {
            const float w = roww[r];
#pragma unroll
            for (int ni = 0; ni < 2; ++ni) {
              const int n = nt * 128 + wn * 64 + ni * 32 + r32;
              atomicAdd((int*)&p.yacc[(size_t)rowtok[r] * DM + n], __float2int_rn(acc[mi][ni][i] * w * 16777216.0f));
            }
          }
        }
#else
      {
        bf16_t* T = (bf16_t*)smem;
#pragma unroll
        for (int mi = 0; mi < 2; ++mi)
#pragma unroll
          for (int i = 0; i < 16; ++i) {
            const int r = wm * 64 + mi * 32 + crow(i, h);
            const float w = roww[r];
#pragma unroll
            for (int ni = 0; ni < 2; ++ni) T[r * 136 + wn * 64 + ni * 32 + r32] = f2bf(acc[mi][ni][i] * w);
          }
        __syncthreads();
        bf16_t* yb = p.yslots + nt * 128;
        epi_flush_bf16<16>(T, 136, 128, [&](int r) { const int slot = rowslot[r]; return slot >= 0 ? yb + (size_t)slot * DM : (bf16_t*)nullptr; });
        __syncthreads();
      }
#endif
    }
  }
}

#endif

#if ORACLE
DI void phase7(const Params& p) {
  const int tid = otid(), lane = tid & 63, wave = __builtin_amdgcn_readfirstlane(tid >> 6);
  const int gw = blockIdx.x * 4 + wave, nw = gridDim.x * 4;
  for (int tok = gw; tok < NT; tok += nw) {
    const int b = tok >> 12;
    float v[16];
    float ss = 0.f;
#pragma unroll
    for (int j = 0; j < 4; ++j) {
      const int col = lane * 4 + 256 * j;
      const float4 hr = *(const float4*)(p.hres + (size_t)tok * DM + col);
      float y[4] = {0.f, 0.f, 0.f, 0.f};
#if ORACLE
      {
        const int4 yi = *(const int4*)(p.yacc + (size_t)tok * DM + col);
        y[0] = (float)yi.x * (1.0f / 16777216.0f); y[1] = (float)yi.y * (1.0f / 16777216.0f); y[2] = (float)yi.z * (1.0f / 16777216.0f); y[3] = (float)yi.w * (1.0f / 16777216.0f);
      }
#else
#pragma unroll
      for (int k = 0; k < NSLOT; ++k) {
        float t4[4];
        ld4f(p.yslots + ((size_t)tok * NSLOT + k) * DM + col, t4);
        y[0] += t4[0]; y[1] += t4[1]; y[2] += t4[2]; y[3] += t4[3];
      }
#endif
      const float4 gt = *(const float4*)(p.mod + b * 6144 + 5120 + col);
      v[4 * j] = hr.x + gt.x * y[0]; v[4 * j + 1] = hr.y + gt.y * y[1]; v[4 * j + 2] = hr.z + gt.z * y[2]; v[4 * j + 3] = hr.w + gt.w * y[3];
      ss += v[4 * j] * v[4 * j] + v[4 * j + 1] * v[4 * j + 1] + v[4 * j + 2] * v[4 * j + 2] + v[4 * j + 3] * v[4 * j + 3];
    }
    ss = wave_sum(ss);
    const float r = 1.0f / sqrtf(ss * (1.0f / DM) + 1e-6f);
#pragma unroll
    for (int j = 0; j < 4; ++j) {
      const int col = lane * 4 + 256 * j;
      const float4 g = *(const float4*)(p.g_final + col);
      __builtin_nontemporal_store(make_f32x4(v[4 * j] * r * g.x, v[4 * j + 1] * r * g.y, v[4 * j + 2] * r * g.z, v[4 * j + 3] * r * g.w), (f32x4*)(p.out + (size_t)tok * DM + col));
    }
  }
}
#else
DI void phase7(const Params& p) {
  const int tid = otid(), lane = tid & 63, wave = __builtin_amdgcn_readfirstlane(tid >> 6);
  const int gw = blockIdx.x * 4 + wave, nw = gridDim.x * 4;
  for (int tok = gw; tok < NT; tok += nw) {
    const int b = tok >> 12;
    float v[16];
    float ss = 0.f;
#pragma unroll
    for (int j = 0; j < 2; ++j) {
      const int col = lane * 8 + 512 * j;
      const float4 hr0 = *(const float4*)(p.hres + (size_t)tok * DM + col), hr1 = *(const float4*)(p.hres + (size_t)tok * DM + col + 4);
      float y[8] = {0.f, 0.f, 0.f, 0.f, 0.f, 0.f, 0.f, 0.f};
#pragma unroll
      for (int k = 0; k < NSLOT; ++k) {
        const u32x4 u = *(const u32x4*)(p.yslots + ((size_t)tok * NSLOT + k) * DM + col);
#pragma unroll
        for (int q = 0; q < 4; ++q) { y[2 * q] += __uint_as_float(u[q] << 16); y[2 * q + 1] += __uint_as_float(u[q] & 0xffff0000u); }
      }
      const float4 gt0 = *(const float4*)(p.mod + b * 6144 + 5120 + col), gt1 = *(const float4*)(p.mod + b * 6144 + 5120 + col + 4);
      float* vv = v + 8 * j;
      vv[0] = hr0.x + gt0.x * y[0]; vv[1] = hr0.y + gt0.y * y[1]; vv[2] = hr0.z + gt0.z * y[2]; vv[3] = hr0.w + gt0.w * y[3];
      vv[4] = hr1.x + gt1.x * y[4]; vv[5] = hr1.y + gt1.y * y[5]; vv[6] = hr1.z + gt1.z * y[6]; vv[7] = hr1.w + gt1.w * y[7];
#pragma unroll
      for (int q = 0; q < 8; ++q) ss += vv[q] * vv[q];
    }
    ss = wave_sum(ss);
    const float r = 1.0f / sqrtf(ss * (1.0f / DM) + 1e-6f);
#pragma unroll
    for (int j = 0; j < 2; ++j) {
      const int col = lane * 8 + 512 * j;
      const float4 g0 = *(const float4*)(p.g_final + col), g1 = *(const float4*)(p.g_final + col + 4);
      const float* vv = v + 8 * j;
      __builtin_nontemporal_store(make_f32x4(vv[0] * r * g0.x, vv[1] * r * g0.y, vv[2] * r * g0.z, vv[3] * r * g0.w), (f32x4*)(p.out + (size_t)tok * DM + col));
      __builtin_nontemporal_store(make_f32x4(vv[4] * r * g1.x, vv[5] * r * g1.y, vv[6] * r * g1.z, vv[7] * r * g1.w), (f32x4*)(p.out + (size_t)tok * DM + col + 4));
    }
  }
}
#endif

struct KArgs { const float* in[23]; float* out; unsigned char* ws; };
struct Carver {
  unsigned char* ws; size_t off;
  __host__ __device__ __forceinline__ unsigned char* take(size_t bytes) { unsigned char* q = ws + off; off = (off + bytes + 255) & ~(size_t)255; return q; }
};
__host__ __device__ __forceinline__ size_t carve(Params& p, unsigned char* ws) {
  Carver c{ws, 0};
  p.mod = (float*)c.take(8 * 6144 * 4);
  p.ropec = (float*)c.take(4096 * 32 * 8);
  p.ropes = nullptr;
  p.kmean = (float*)c.take(8 * 8 * 16 * 64 * 4);
  p.cnt = (int*)c.take((size_t)(NEXP + 1) * CNT_STRIDE * 4);
  p.ctr = (int*)c.take(256);
  p.bar = (unsigned*)c.take(XCD_BAR_WORDS * 4);
  p.selw = (float*)c.take((size_t)NT * NSLOT * 4);
  p.winT = (bf16_t*)c.take((size_t)2560 * LDH * 2); p.winTl = (bf16_t*)c.take((size_t)2560 * LDH * 2);
  p.woutT = (bf16_t*)c.take((size_t)1024 * 1024 * 2); p.woutTl = (bf16_t*)c.take((size_t)1024 * 1024 * 2);
  p.wrT = (bf16_t*)c.take((size_t)256 * 1024 * 2); p.wrTl = (bf16_t*)c.take((size_t)256 * 1024 * 2);
  p.w1kT = (bf16_t*)c.take((size_t)256 * 2048 * 2); p.w1kTl = (bf16_t*)c.take((size_t)256 * 2048 * 2);
  p.w1vT = (bf16_t*)c.take((size_t)256 * 2048 * 2); p.w1vTl = (bf16_t*)c.take((size_t)256 * 2048 * 2);
  p.w2kT = (bf16_t*)c.take((size_t)128 * 256 * 2); p.w2kTl = (bf16_t*)c.take((size_t)128 * 256 * 2);
  p.w2vT = (bf16_t*)c.take((size_t)128 * 256 * 2); p.w2vTl = (bf16_t*)c.take((size_t)128 * 256 * 2);
  p.hres = (float*)c.take((size_t)NT * DM * 4);
  p.h2 = (act_t*)c.take((size_t)NT * DM * sizeof(act_t));
  p.list = (int*)c.take((size_t)NEXP * CAP * 4);
  const size_t uoff = c.off;
  p.proj = (act_t*)c.take((size_t)(NT + 64) * NP * sizeof(act_t));
  p.vT_slc = (act_t*)c.take((size_t)80 * 64 * SEQ * sizeof(act_t));
  p.vT_win = p.vT_slc + (size_t)8 * 64 * SEQ;
  p.vT_moba = p.vT_slc + (size_t)16 * 64 * SEQ;
  p.hid = nullptr;
  p.hidp = (float*)c.take((size_t)4 * 2 * 2048 * 256 * 4);
  p.kc = (act_t*)c.take((size_t)8 * 256 * 64 * sizeof(act_t));
  p.vcT = (act_t*)c.take((size_t)8 * 64 * 256 * sizeof(act_t));
  p.mixacc = (float*)c.take((size_t)NT * 512 * 4);
  p.mix = (act_t*)c.take((size_t)NT * LDH * sizeof(act_t));
  p.h1 = p.mix;
  const size_t end_a = c.off;
  c.off = uoff;
#if ORACLE
  p.abuf = (act_t*)c.take((size_t)512 * 128 * 256 * sizeof(act_t));
  p.scores = (float*)c.take((size_t)NT * 256 * 4);
  p.yacc = (float*)c.take((size_t)NT * DM * 4);
  p.yslots = nullptr;
  p.h2lo = (bf16_t*)c.take((size_t)NT * DM * 2);
#else
  p.abuf = (act_t*)c.take((size_t)1408 * 256 * 256 * sizeof(act_t));
  p.scores = (float*)p.abuf;
  p.yacc = nullptr;
  p.yslots = (act_t*)c.take((size_t)NT * NSLOT * DM * sizeof(act_t));
  p.h2lo = (bf16_t*)p.yslots;
#endif
  const size_t end_b = c.off;
  return end_a > end_b ? end_a : end_b;
}
typedef const __attribute__((address_space(4))) KArgs* KArgsPtr;
DI Params expand() {
  KArgsPtr ka = (KArgsPtr)__builtin_amdgcn_kernarg_segment_ptr();
  asm volatile("" : "+s"(ka));
  Params p;
  p.x = ka->in[0]; p.c = ka->in[1]; p.w_ada = ka->in[2]; p.b_ada = ka->in[3]; p.g_attn = ka->in[4]; p.w_in = ka->in[5];
  p.pos_k = ka->in[6]; p.w1_k = ka->in[7]; p.w2_k = ka->in[8]; p.pos_v = ka->in[9]; p.w1_v = ka->in[10]; p.w2_v = ka->in[11];
  p.w_out = ka->in[12]; p.g_ffn = ka->in[13]; p.w_router = ka->in[14]; p.router_bias = ka->in[15];
  p.w_eg = ka->in[16]; p.w_eu = ka->in[17]; p.w_ed = ka->in[18]; p.w_sg = ka->in[19]; p.w_su = ka->in[20]; p.w_sd = ka->in[21]; p.g_final = ka->in[22];
  p.out = ka->out;
  unsigned char* ws = ka->ws;
  carve(p, ws);
  return p;
}

__global__ void __launch_bounds__(NTHREADS, ORACLE ? 1 : 2) fwd_megakernel(KArgs ka_unused) {
  __shared__ __attribute__((aligned(16))) unsigned char smem[SMEM_BYTES + 32];
  uint4* xb_words = (uint4*)(smem + SMEM_BYTES + 16);
  if (threadIdx.x == 0) *xb_words = make_uint4(0u, 0u, 0u, 0u);
  __syncthreads();
  XcdBarrier xb;
  { const Params p = expand(); xb = xcd_barrier_post(p.bar, (volatile LAS unsigned*)xb_words); }
  { const Params p = expand(); phase0<0>(p, smem); }
  xcd_barrier(xb);
  { const Params p = expand(); phase0<1>(p, smem); phase0b(p); }
  xcd_barrier(xb);
  { const Params p = expand(); phase1(p, smem); }
  xcd_barrier(xb);
  { const Params p = expand(); phase2a(p, smem); }
  xcd_barrier(xb);
  { const Params p = expand(); phase2b(p, smem); }
  xcd_barrier(xb);
  { const Params p = expand(); phase3(p, smem); }
  xcd_barrier(xb);
  { const Params p = expand(); phase4(p, smem); }
  xcd_barrier(xb);
  { const Params p = expand(); phase5pre(p); }
  xcd_barrier(xb);
  { const Params p = expand(); phase5a(p, smem); }
  xcd_barrier(xb);
  { const Params p = expand(); phase5b(p); }
  xcd_barrier(xb);
#if BIG6X
  { const Params p = expand(); phase6a(p, smem); }
  xcd_barrier(xb);
  { const Params p = expand(); phase6b(p, smem); }
#else
  { const Params p = expand(); phase6(p, smem); }
#endif
  xcd_barrier(xb);
  { const Params p = expand(); phase7(p); }
}

extern "C" void kernel_launch(void* const* d_in, const int* in_sizes, int n_in, void* d_out, int out_size, void* d_ws, size_t ws_size,
                              hipStream_t stream) {
  static int grid_blocks = 0;
  if (!grid_blocks) {
    int dev = 0, cus = 0, per_cu = 0;
    hipGetDevice(&dev);
    hipDeviceGetAttribute(&cus, hipDeviceAttributeMultiprocessorCount, dev);
    hipOccupancyMaxActiveBlocksPerMultiprocessor(&per_cu, fwd_megakernel, NTHREADS, 0);
    if (per_cu > 2) per_cu = 2;
    if (per_cu < 1) per_cu = 1;
    grid_blocks = cus * per_cu;
  }
  KArgs ka{};
  for (int i = 0; i < 23; ++i) ka.in[i] = (const float*)d_in[i];
  ka.out = (float*)d_out;
  ka.ws = (unsigned char*)d_ws;
  Params p{};
  const size_t need = carve(p, ka.ws);
  if (need > ws_size) { fprintf(stderr, "kernel_launch: workspace too small: need %zu have %zu\n", need, ws_size); return; }
  if (hipMemsetAsync(p.bar, 0, XCD_BAR_WORDS * 4, stream) != hipSuccess) { fprintf(stderr, "kernel_launch: memset of barrier words failed\n"); return; }
  void* args[] = {&ka};
  hipError_t e = hipLaunchCooperativeKernel((void*)fwd_megakernel, dim3(grid_blocks), dim3(NTHREADS), args, 0, stream);
  if (e != hipSuccess) fprintf(stderr, "cooperative launch failed: %s (grid %d)\n", hipGetErrorString(e), grid_blocks);
}
```
